# Optimizing an MI355X kernel written in HIP

```python
import math
import jax, jax.numpy as jnp
from jax import lax
import numpy as np

D_MODEL = 2048
BATCH = 16
SEQ = 2048
DEPTH = 4

N_META = 16
N_MIXERS = 2
MIX_WIDTH = D_MODEL
RMS_EPS = 1e-6
S5_GROUP = 16
S5_GROUPS = MIX_WIDTH // S5_GROUP
S5_STATE = 64
S5_CHUNK = 128
DT_MIN = 1e-3
DT_MAX = 1e-1
POOL_WINDOWS = (2, 4, 8, 16)
POOL_GROUPS = len(POOL_WINDOWS)
POOL_GROUP_WIDTH = MIX_WIDTH // POOL_GROUPS
N_EXPERT_GROUPS = 4
EXPERTS_PER_GROUP = 8
N_EXPERTS = N_EXPERT_GROUPS * EXPERTS_PER_GROUP
TOP_K_INNER = 2
D_EXPERT = D_MODEL // 4

kernel_name = 'hybrid_s5_pool_hmoe_trunk'

F32 = jnp.float32


def rms_norm(h, g):
    hf = h.astype(F32)
    y = hf * lax.rsqrt(jnp.mean(hf * hf, axis=-1, keepdims=True) + RMS_EPS) * g.astype(F32)
    return y.astype(h.dtype)


def s5_mixer(h, w_in, a_re, a_im, log_dt, b_re, b_im, c_re, c_im, d_skip, w_glu):
    bsz, t_len, _ = h.shape
    u = (h @ w_in).astype(F32).reshape(bsz, t_len, S5_GROUPS, S5_GROUP)
    dt = jnp.exp(log_dt.astype(F32))[:, None]
    lr, li = a_re.astype(F32), a_im.astype(F32)
    mag = jnp.exp(lr * dt)
    abar_re = mag * jnp.cos(li * dt)
    abar_im = mag * jnp.sin(li * dt)
    den = lr * lr + li * li
    nr, ni = abar_re - 1.0, abar_im
    coef_re = (nr * lr + ni * li) / den
    coef_im = (ni * lr - nr * li) / den
    br, bi = b_re.astype(F32), b_im.astype(F32)
    bbar_re = coef_re[..., None] * br - coef_im[..., None] * bi
    bbar_im = coef_re[..., None] * bi + coef_im[..., None] * br
    cr, ci = c_re.astype(F32), c_im.astype(F32)

    def combine(e1, e2):
        a1r, a1i, b1r, b1i = e1
        a2r, a2i, b2r, b2i = e2
        return (a1r * a2r - a1i * a2i, a1r * a2i + a1i * a2r,
                a2r * b1r - a2i * b1i + b2r, a2r * b1i + a2i * b1r + b2i)

    def chunk_scan(u_c, h0_re, h0_im):
        bu_re = jnp.einsum('blgh,gph->blgp', u_c, bbar_re)
        bu_im = jnp.einsum('blgh,gph->blgp', u_c, bbar_im)
        ar = jnp.broadcast_to(abar_re, bu_re.shape)
        ai = jnp.broadcast_to(abar_im, bu_re.shape)
        pr, pi, sr, si = lax.associative_scan(combine, (ar, ai, bu_re, bu_im), axis=1)
        xr = sr + pr * h0_re[:, None] - pi * h0_im[:, None]
        xi = si + pr * h0_im[:, None] + pi * h0_re[:, None]
        y = jnp.einsum('blgp,ghp->blgh', xr, cr) - jnp.einsum('blgp,ghp->blgh', xi, ci)
        return y, xr[:, -1], xi[:, -1]

    zeros = jnp.zeros((bsz, S5_GROUPS, S5_STATE), F32)
    y_meta, h_re, h_im = chunk_scan(u[:, :N_META], zeros, zeros)
    n_chunks = (t_len - N_META) // S5_CHUNK
    u_real = u[:, N_META:].reshape(bsz, n_chunks, S5_CHUNK, S5_GROUPS, S5_GROUP)
    u_real = jnp.moveaxis(u_real, 1, 0)

    def body(carry, u_c):
        y_c, hr, hi = chunk_scan(u_c, carry[0], carry[1])
        return (hr, hi), y_c

    _, y_chunks = lax.scan(body, (h_re, h_im), u_real)
    y_real = jnp.moveaxis(y_chunks, 0, 1).reshape(bsz, t_len - N_META, S5_GROUPS, S5_GROUP)
    y = jnp.concatenate([y_meta, y_real], axis=1)
    y = y + d_skip.astype(F32).reshape(S5_GROUPS, S5_GROUP) * u
    z = jax.nn.gelu(y.reshape(bsz, t_len, MIX_WIDTH))
    vg = z @ w_glu
    out = vg[..., :D_MODEL] * jax.nn.sigmoid(vg[..., D_MODEL:])
    return out.astype(h.dtype)


def pool_mixer(h, w_in, w_grp, scale):
    bsz, t_len, _ = h.shape
    u = (h @ w_in).astype(F32).reshape(bsz, t_len, POOL_GROUPS, POOL_GROUP_WIDTH)
    cs = jnp.cumsum(u, axis=1)
    t_idx = jnp.arange(t_len)
    pooled = []
    for g, w in enumerate(POOL_WINDOWS):
        csg = cs[:, :, g]
        lag = jnp.pad(csg, ((0, 0), (w, 0), (0, 0)))[:, :t_len]
        cnt = jnp.minimum(t_idx + 1, w).astype(F32)[None, :, None]
        pooled.append((csg - lag) / cnt)
    pooled = jnp.stack(pooled, axis=2)
    mixed = pooled - u
    y = jnp.einsum('btgc,gcd->btgd', mixed, w_grp.astype(F32)).reshape(bsz, t_len, D_MODEL)
    return (y * scale.astype(F32)).astype(h.dtype)


def hier_moe(h, w_coarse, b_coarse, w_fine, b_fine, w_gate, w_up, w_down):
    bsz, t_len, d = h.shape
    xt = h.reshape(-1, d)
    n_tok = xt.shape[0]
    coarse_p = jax.nn.softmax((xt @ w_coarse).astype(F32) + b_coarse.astype(F32), axis=-1)
    p_grp, grp = lax.top_k(coarse_p, 1)
    fine_logits = ((xt @ w_fine).astype(F32) + b_fine.astype(F32)).reshape(n_tok, N_EXPERT_GROUPS, EXPERTS_PER_GROUP)
    idx = jnp.broadcast_to(grp[:, :, None], (n_tok, 1, EXPERTS_PER_GROUP))
    fine_sel = jnp.take_along_axis(fine_logits, idx, axis=1)[:, 0]
    p_exp, exp_local = lax.top_k(jax.nn.softmax(fine_sel, axis=-1), TOP_K_INNER)
    w_exp = p_exp / jnp.sum(p_exp, axis=-1, keepdims=True) * p_grp
    exp_idx = grp * EXPERTS_PER_GROUP + exp_local
    gates = jnp.sum(jax.nn.one_hot(exp_idx, N_EXPERTS, dtype=F32) * w_exp[..., None], axis=1)
    out = jnp.zeros((n_tok, d), F32)
    for e in range(N_EXPERTS):
        hid = jax.nn.silu(xt @ w_gate[e]) * (xt @ w_up[e])
        out = out + gates[:, e:e + 1] * (hid @ w_down[e]).astype(F32)
    return out.astype(h.dtype).reshape(bsz, t_len, d)


def setup_inputs(seed: int = 0) -> dict:
    key = jax.random.key(seed)
    ks = iter(jax.random.split(key, 40))
    n_a = (DEPTH + N_MIXERS - 1) // N_MIXERS
    n_b = DEPTH // N_MIXERS

    def nrm(shape, scale):
        return jax.random.normal(next(ks), shape, F32) * scale

    ns = jnp.arange(S5_STATE, dtype=F32)
    return {
        'x': nrm((BATCH, SEQ, D_MODEL), 1.0),
        'meta_tokens': nrm((N_META, D_MODEL), 1.0),
        'norm_mix': 1.0 + nrm((DEPTH, D_MODEL), 0.02),
        'norm_ffn': 1.0 + nrm((DEPTH, D_MODEL), 0.02),
        'norm_final': 1.0 + nrm((D_MODEL,), 0.02),
        's5_w_in': nrm((n_a, D_MODEL, MIX_WIDTH), D_MODEL ** -0.5),
        's5_a_re': -0.5 + nrm((n_a, S5_GROUPS, S5_STATE), 0.01),
        's5_a_im': jnp.pi * ns + nrm((n_a, S5_GROUPS, S5_STATE), 0.01),
        's5_log_dt': jax.random.uniform(next(ks), (n_a, S5_GROUPS), F32, math.log(DT_MIN), math.log(DT_MAX)),
        's5_b_re': nrm((n_a, S5_GROUPS, S5_STATE, S5_GROUP), (2 * S5_GROUP) ** -0.5),
        's5_b_im': nrm((n_a, S5_GROUPS, S5_STATE, S5_GROUP), (2 * S5_GROUP) ** -0.5),
        's5_c_re': nrm((n_a, S5_GROUPS, S5_GROUP, S5_STATE), S5_STATE ** -0.5),
        's5_c_im': nrm((n_a, S5_GROUPS, S5_GROUP, S5_STATE), S5_STATE ** -0.5),
        's5_d': nrm((n_a, MIX_WIDTH), 1.0),
        's5_w_glu': nrm((n_a, MIX_WIDTH, 2 * D_MODEL), MIX_WIDTH ** -0.5),
        'pool_w_in': nrm((n_b, D_MODEL, MIX_WIDTH), D_MODEL ** -0.5),
        'pool_w_grp': nrm((n_b, POOL_GROUPS, POOL_GROUP_WIDTH, POOL_GROUP_WIDTH), POOL_GROUP_WIDTH ** -0.5),
        'pool_scale': 1.0 + nrm((n_b, D_MODEL), 0.02),
        'moe_w_coarse': nrm((DEPTH, D_MODEL, N_EXPERT_GROUPS), D_MODEL ** -0.5),
        'moe_b_coarse': nrm((DEPTH, N_EXPERT_GROUPS), 0.01),
        'moe_w_fine': nrm((DEPTH, D_MODEL, N_EXPERTS), D_MODEL ** -0.5),
        'moe_b_fine': nrm((DEPTH, N_EXPERTS), 0.01),
        'moe_w_gate': nrm((DEPTH, N_EXPERTS, D_MODEL, D_EXPERT), D_MODEL ** -0.5),
        'moe_w_up': nrm((DEPTH, N_EXPERTS, D_MODEL, D_EXPERT), D_MODEL ** -0.5),
        'moe_w_down': nrm((DEPTH, N_EXPERTS, D_EXPERT, D_MODEL), D_EXPERT ** -0.5),
    }


def reference(x, meta_tokens, norm_mix, norm_ffn, norm_final,
              s5_w_in, s5_a_re, s5_a_im, s5_log_dt, s5_b_re, s5_b_im, s5_c_re, s5_c_im, s5_d, s5_w_glu,
              pool_w_in, pool_w_grp, pool_scale,
              moe_w_coarse, moe_b_coarse, moe_w_fine, moe_b_fine, moe_w_gate, moe_w_up, moe_w_down):
    bsz = x.shape[0]
    meta = jnp.broadcast_to(meta_tokens[None].astype(x.dtype), (bsz, N_META, D_MODEL))
    h = jnp.concatenate([meta, x], axis=1)
    for i in range(DEPTH):
        hn = rms_norm(h, norm_mix[i])
        j = i // N_MIXERS
        if i % N_MIXERS == 0:
            h = h + s5_mixer(hn, s5_w_in[j], s5_a_re[j], s5_a_im[j], s5_log_dt[j], s5_b_re[j], s5_b_im[j],
                             s5_c_re[j], s5_c_im[j], s5_d[j], s5_w_glu[j])
        else:
            h = h + pool_mixer(hn, pool_w_in[j], pool_w_grp[j], pool_scale[j])
        h = h + hier_moe(rms_norm(h, norm_ffn[i]), moe_w_coarse[i], moe_b_coarse[i], moe_w_fine[i],
                         moe_b_fine[i], moe_w_gate[i], moe_w_up[i], moe_w_down[i])
    h = rms_norm(h, norm_final)
    return h[:, N_META:]
```

```cpp
#include <hip/hip_runtime.h>
#include <cstdio>
#include <cstdint>

#ifndef ONE_LAUNCH
#define ONE_LAUNCH 1
#endif

#define DBG_SRC WS_H
#ifndef REP_P0
#define REP_P0 1
#endif
#ifndef REP_WIN
#define REP_WIN 1
#endif
#ifndef REP_S5
#define REP_S5 1
#endif
#ifndef REP_POOL
#define REP_POOL 1
#endif
#ifndef REP_GU
#define REP_GU 1
#endif
#ifndef REP_DN
#define REP_DN 1
#endif

#ifndef EN_P0
#define EN_P0 1
#endif
#ifndef EN_WIN
#define EN_WIN 1
#endif
#ifndef EN_S51
#define EN_S51 1
#endif
#ifndef EN_S52
#define EN_S52 1
#endif
#ifndef EN_GLU
#define EN_GLU 1
#endif
#ifndef EN_POOL
#define EN_POOL 1
#endif
#ifndef EN_GRP
#define EN_GRP 1
#endif
#ifndef EN_RT
#define EN_RT 1
#endif
#ifndef EN_GU
#define EN_GU 1
#endif
#ifndef EN_DN
#define EN_DN 1
#endif
#ifndef EN_CMB
#define EN_CMB 1
#endif
#define LAS __attribute__((address_space(3)))
typedef unsigned short bf16_t;
typedef short s16x8 __attribute__((ext_vector_type(8)));
typedef short s16x4 __attribute__((ext_vector_type(4)));
typedef float f32x4 __attribute__((ext_vector_type(4)));
typedef float f32x2 __attribute__((ext_vector_type(2)));
typedef unsigned u32x4 __attribute__((ext_vector_type(4)));
typedef unsigned u32x2 __attribute__((ext_vector_type(2)));
typedef int i32x4 __attribute__((ext_vector_type(4)));

constexpr int D = 2048, NB = 16, SEQ = 2048, NMETA = 16, TT = SEQ + NMETA;
constexpr int NREAL = NB * SEQ;
constexpr int NROWS = NREAL + NMETA;
constexpr int NE = 32, DE = 512, CAP = NROWS, NSLOT = 2 * NROWS;
constexpr int NG = 128, NST = 64;
constexpr int NCH = 16, CL = SEQ / NCH;
constexpr float RMS_EPS = 1e-6f;
constexpr int NWAVES = 8, NTHR = 512;
constexpr size_t SI_RANK = 32ull * (NREAL + NMETA) * 16 + 65536;

__device__ __forceinline__ int rowidx(int b, int tt) { return tt < NMETA ? NREAL + tt : b * SEQ + (tt - NMETA); }

constexpr size_t CTL_BYTES = 131072;
constexpr int CW_CNT = 8192;
constexpr int CW_AM = 16384;
constexpr float QCLIP = 6.0f;
constexpr size_t WS_WIN  = CTL_BYTES;
constexpr size_t WS_GLU  = WS_WIN  + 4ull * 2048 * 2048 * 2;
constexpr size_t WS_GRP  = WS_GLU  + 2ull * 4096 * 2048 * 2;
constexpr size_t WS_GU   = WS_GRP  + 2ull * 2048 * 512 * 2;
constexpr size_t WS_DN   = WS_GU   + 4ull * 32 * 1024 * 2048 * 2;
constexpr size_t WS_RT   = WS_DN   + 4ull * 32 * 2048 * 512 * 2;
constexpr size_t WS_S5A  = WS_RT   + 4ull * 64 * 3 * 64 * 16;
constexpr size_t WS_S5L  = WS_S5A  + 2ull * 128 * 2 * 64 * 4;
constexpr size_t WS_S5B  = WS_S5L  + 2ull * 128 * 2 * 64 * 4;
constexpr size_t WS_S5C  = WS_S5B  + 2ull * 128 * 8 * 64 * 8;
constexpr size_t WS_S5T  = WS_S5C  + 2ull * 128 * 8 * 64 * 8;
constexpr size_t WS_H    = WS_S5T  + 2ull * 128 * 3 * 32768;
constexpr size_t WS_U    = WS_H    + (size_t)NROWS * 2048 * 2;
constexpr size_t WS_WINO = WS_U;
constexpr size_t WS_Z    = WS_U    + (size_t)NROWS * 2048 * 2;
constexpr size_t WS_Z8   = WS_Z;
constexpr size_t WS_ZM   = WS_Z + 100ull * 1024 * 1024;
constexpr size_t WS_RSTD = WS_Z    + (size_t)NROWS * 2048 * 2;
constexpr size_t WS_SLOC = WS_RSTD + (size_t)33024 * 4 + 256;
constexpr size_t WS_SINF = WS_SLOC + 128ull * (NCH + 1) * 32 * 64 * 4;
constexpr size_t WS_SSP  = WS_SINF + 2 * (32ull * CAP * 16 + 65536);
constexpr size_t WS_HID  = WS_SSP  + (size_t)33024 * 32 * 4;
constexpr size_t WS_Y    = WS_HID  + (size_t)(NSLOT + 256) * 512 * 2;
constexpr size_t WS_HI8  = WS_Y + 128ull * 1024 * 1024;
constexpr size_t WS_WI8  = WS_Y + 200ull * 1024 * 1024;
constexpr size_t WS_RQ   = WS_Y + 224ull * 1024 * 1024;
constexpr size_t WS_SC   = WS_Y + 65ull * 1024 * 1024;
constexpr int CW_CC = CW_CNT + 256;
constexpr int NCLS = 112;
constexpr size_t WS_GLU8 = WS_Y + 226ull * 1024 * 1024;
constexpr size_t WS_H8   = WS_Y;
constexpr size_t WS_END  = WS_Y    + (size_t)(NSLOT + 256) * 2048 * 2;

constexpr int LDS_STAGE = 0;
constexpr int LDS_INFO  = 131072;
constexpr int LDS_MISC  = 131072 + 12288;
constexpr int LDS_BYTES = 147456;

typedef __bf16 bf16x2_t __attribute__((ext_vector_type(2)));
__device__ __forceinline__ unsigned cvt_pk_bf16(float lo, float hi) { const f32x2 v = {lo, hi}; union { bf16x2_t b; unsigned u; } c; c.b = __builtin_convertvector(v, bf16x2_t); return c.u; }
typedef long i64x2 __attribute__((ext_vector_type(2)));
typedef int i32x8 __attribute__((ext_vector_type(8)));
__device__ __forceinline__ unsigned cvt_pk4_fp8(float a, float b, float c, float d) { int w = __builtin_amdgcn_cvt_pk_fp8_f32(a, b, 0, false); w = __builtin_amdgcn_cvt_pk_fp8_f32(c, d, w, true); return (unsigned)w; }
__device__ __forceinline__ unsigned q8(float x) { return (unsigned)(int)__builtin_rintf(__builtin_amdgcn_fmed3f(x, -127.f, 127.f)) & 0xffu; }
__device__ __forceinline__ u32x2 pack8_i8(const f32x4 a, const f32x4 b) {
    return (u32x2){q8(a[0]) | (q8(a[1]) << 8) | (q8(a[2]) << 16) | (q8(a[3]) << 24), q8(b[0]) | (q8(b[1]) << 8) | (q8(b[2]) << 16) | (q8(b[3]) << 24)}; }
__device__ __forceinline__ float bf_lo(unsigned w) { return __uint_as_float(w << 16); }
__device__ __forceinline__ float bf_hi(unsigned w) { return __uint_as_float(w & 0xffff0000u); }
__device__ __forceinline__ int rfl(int v) { return __builtin_amdgcn_readfirstlane(v); }
__device__ __forceinline__ float sigmoid_f(float x) { return __builtin_amdgcn_rcpf(1.0f + __expf(-x)); }
__device__ __forceinline__ float wave_sum(float v) {
#pragma unroll
    for (int o = 1; o < 64; o <<= 1) v += __shfl_xor(v, o);
    return v;
}
__device__ __forceinline__ int opaque_lane() { int l; asm volatile("v_mbcnt_lo_u32_b32 %0, -1, 0\n\tv_mbcnt_hi_u32_b32 %0, -1, %0" : "=v"(l)); return l; }
#define LDS_WAIT() asm volatile("s_waitcnt lgkmcnt(0)" ::: "memory")
#define VM_WAIT()  asm volatile("s_waitcnt vmcnt(0)" ::: "memory")

#define XB_TMO      128
#define XB_XCNT(j)  (256  + 64 * (j))
#define XB_XSUB(j)  (1280 + 64 * (j))
#define XB_XGEN(j)  (2304 + 64 * (j))
#define XB_TOP      3328
#define XB_TOPGEN   3392
#define XCD_BAR_WORDS 3456
#define XB_SPIN_CAP (1u << 22)

__device__ __forceinline__ unsigned xb_ld(unsigned* p)              { return __hip_atomic_load(p, __ATOMIC_RELAXED, __HIP_MEMORY_SCOPE_AGENT); }
__device__ __forceinline__ unsigned xb_add(unsigned* p, unsigned v) { return __hip_atomic_fetch_add(p, v, __ATOMIC_RELAXED, __HIP_MEMORY_SCOPE_AGENT); }
__device__ __forceinline__ unsigned xb_xcc_id() { return (unsigned)__builtin_amdgcn_s_getreg((3 << 11) | 20) & 0xFu; }
#define XB_SPIN(cond, bar) do { unsigned _sp = 0; while (cond) { __builtin_amdgcn_s_sleep(1); \
    if ((++_sp & 255u) == 0u) { if (xb_ld(&(bar)[XB_TMO])) break; if (_sp > XB_SPIN_CAP) { atomicAdd(&(bar)[XB_TMO], 1u); break; } } } } while (0)

struct XcdBarrier { unsigned* bar; unsigned x; volatile LAS unsigned* st; };

__device__ __forceinline__ XcdBarrier xcd_barrier_post(unsigned* bar, volatile LAS unsigned* st) {
    XcdBarrier b; b.bar = bar; b.x = xb_xcc_id(); b.st = st;
    if (threadIdx.x == 0) (void)xb_add(&bar[XB_XCNT(b.x)], 1u);
    return b;
}
__device__ __forceinline__ void xcd_barrier_complete(unsigned* bar, unsigned x, unsigned& nloc, unsigned& nx) {
    const unsigned G = gridDim.x * gridDim.y * gridDim.z;
    unsigned sum, cnt, mine, sp = 0u;
    for (;;) {
        sum = 0u; cnt = 0u; mine = 0u;
#pragma unroll
        for (unsigned j = 0; j < 16; ++j) { const unsigned c = xb_ld(&bar[XB_XCNT(j)]); sum += c; cnt += (c > 0u) ? 1u : 0u; mine = (j == x) ? c : mine; }
        if (sum == G) break;
        __builtin_amdgcn_s_sleep(1);
        if ((++sp & 255u) == 0u) { if (xb_ld(&bar[XB_TMO])) break; if (sp > XB_SPIN_CAP) { atomicAdd(&bar[XB_TMO], 1u); break; } }
    }
    nloc = mine > 0u ? mine : 1u; nx = cnt > 0u ? cnt : 1u;
}
__device__ __forceinline__ void xcd_barrier(const XcdBarrier& b) {
    asm volatile("s_waitcnt vmcnt(0)" ::: "memory");
    __syncthreads();
    if (threadIdx.x == 0) {
        unsigned* bar = b.bar;
        __builtin_amdgcn_s_waitcnt(0);
        unsigned nloc = b.st[0], nx = b.st[1];
        if (nloc == 0u) { xcd_barrier_complete(bar, b.x, nloc, nx); b.st[0] = nloc; b.st[1] = nx; }
        const unsigned old = xb_add(&bar[XB_XSUB(b.x)], 1u);
        const unsigned gen = old / nloc;
        if (old + 1u == (gen + 1u) * nloc) {
            __builtin_amdgcn_fence(__ATOMIC_RELEASE, "agent");
            asm volatile("s_waitcnt vmcnt(0)" ::: "memory");
            const unsigned og = xb_add(&bar[XB_TOP], 1u);
            const unsigned tg = og / nx;
            if (og + 1u == (tg + 1u) * nx) xb_add(&bar[XB_TOPGEN], 1u);
            else XB_SPIN(xb_ld(&bar[XB_TOPGEN]) == tg, bar);
            __builtin_amdgcn_fence(__ATOMIC_ACQUIRE, "agent");
            xb_add(&bar[XB_XGEN(b.x)], 1u);
            asm volatile("s_waitcnt vmcnt(0)" ::: "memory");
        } else {
            XB_SPIN(xb_ld(&bar[XB_XGEN(b.x)]) == gen, bar);
            __builtin_amdgcn_fence(__ATOMIC_ACQUIRE, "agent");
            asm volatile("s_waitcnt vmcnt(0)" ::: "memory");
        }
    }
    __syncthreads();
}

namespace gm {
constexpr int BM = 256, BK = 64, HALF = 128, HTB = HALF * BK * 2, NXCD = 8, WGM = 8;
__host__ __device__ __forceinline__ int lds_byte(int r, int c) { const int st = (r >> 4) * 2 + (c >> 5), rr = r & 15, cc = c & 31, ob = rr * 64 + cc * 2; return st * 1024 + (ob ^ (((ob >> 9) & 1) << 5)); }
__host__ __device__ __forceinline__ void stage_rc(int b, int& R, int& C) { const int st = b / 1024, sb = b % 1024, swz = sb ^ (((sb >> 9) & 1) << 5); R = (st >> 1) * 16 + swz / 64; C = (st & 1) * 32 + (swz % 64) / 2; }
__host__ __device__ __forceinline__ int perm32(int rho) { const int n = rho >> 4, i = rho & 15; return 8 * (i >> 2) + 4 * n + (i & 3); }

struct Unit { const char* a; const char* b; const char* b2; const char* info; const char* info1; int rows, orow, pn, split, half, seq; };

struct DenseOrder {
    int nM, nN, nwg, G, c; const char* A; const char* Bt; size_t aTile, bTile; int kofs_per_pn2; int kofsB_per_pm2 = 0;
    __device__ __forceinline__ bool next(int i, Unit& u) const {
        const long L = (long)i * G + c; if (L >= nwg) return false;
        int wgid = (int)L; { const int q = nwg / NXCD, r = nwg % NXCD, xcd = wgid % NXCD, off = wgid / NXCD; wgid = (xcd < r ? xcd * (q + 1) : r * (q + 1) + (xcd - r) * q) + off; }
        const int nig = WGM * nN, gid = wgid / nig, fm = gid * WGM, gsz = (nM - fm) < WGM ? (nM - fm) : WGM;
        const int pm = fm + ((wgid % nig) % gsz), pn = (wgid % nig) / gsz;
        u.a = A + (size_t)pm * aTile + (size_t)(pn >> 1) * kofs_per_pn2; u.b = Bt + (size_t)pn * bTile + (size_t)(pm >> 1) * kofsB_per_pm2; u.info = nullptr; u.info1 = nullptr; u.split = 256; u.half = 0; u.seq = i; u.rows = 256; u.orow = pm * 256; u.pn = pn; return true;
    }
};
struct MoeOrder {
    int nN, G, c, mode; const LAS int* tp; const LAS int* sbe; const LAS int* c0; const char* A; size_t aRow; const char* Bt; size_t bExp, bTile; const char* info;
    __device__ __forceinline__ bool next(int i, Unit& u) const {
        const int T = rfl(tp[32]);
        const int nfull = (((T * nN) / G) * G) / nN, nFullU = nfull * nN, nHalfU = (T - nfull) * 2 * nN;
        const long L = (long)i * G + c; if (L >= nFullU + nHalfU) return false;
        const int hf = L >= nFullU ? 1 : 0; const int nwg = hf ? nHalfU : nFullU;
        int wgid = (int)L - (hf ? nFullU : 0); { const int q = nwg / NXCD, r = nwg % NXCD, xcd = wgid % NXCD, off = wgid / NXCD; wgid = (xcd < r ? xcd * (q + 1) : r * (q + 1) + (xcd - r) * q) + off; }
        const int tix = wgid / nN, pn = wgid % nN, mtg = hf ? nfull + (tix >> 1) : tix, r0 = hf ? 128 * (tix & 1) : 0;
        const int ln = (int)__builtin_amdgcn_mbcnt_hi(~0u, __builtin_amdgcn_mbcnt_lo(~0u, 0u));
        const int tv = tp[ln < 32 ? ln : 32];
        const int e = __builtin_popcountll(__ballot(ln >= 1 && ln < 32 && tv <= mtg));
        const int mt = mtg - rfl(tp[e]); const int s0 = rfl(sbe[e]), s1 = rfl(sbe[e + 1]), n0 = rfl(c0[e]);
        const int cntE = mode == 0 ? (s1 - s0) : (mode == 1 ? n0 : (s1 - s0) - n0);
        const int rem = cntE - 256 * mt - r0, cap = hf ? 128 : 256;
        u.rows = rem < cap ? (rem < 0 ? 0 : rem) : cap; u.orow = s0 + (mode == 2 ? n0 : 0) + 256 * mt + r0; u.pn = pn; u.half = hf;
        const char* ib = info + ((size_t)e * CAP + (size_t)(256 * mt + r0)) * 16;
        if (mode == 0) { u.info = ib; u.info1 = ib + SI_RANK - (size_t)n0 * 16; u.split = n0 - 256 * mt - r0; }
        else { u.info = mode == 1 ? ib : ib + SI_RANK; u.info1 = u.info; u.split = 256; }
        u.b = Bt + (size_t)e * bExp + (size_t)pn * bTile;
        u.a = mode == 0 ? A : A + (size_t)u.orow * aRow;
        return true;
    }
};

struct PairOrder {
    int nN, G, c; const LAS int* tp; const LAS int* tph; const LAS int* ncl; const LAS int* ptab; const char* A; const char* Bt; size_t bExp, bTile; const char* info;
    __device__ __forceinline__ bool next(int i, Unit& u) const {
        const int TF = rfl(tp[NCLS]), TH = rfl(tph[NCLS]);
        const int nFullU = TF * nN, nHalfU = TH * nN;
        { const int cntc = (nFullU + nHalfU - c + G - 1) / G; if (i >= cntc) return false;
          const int nf = c < nFullU ? (nFullU - c + G - 1) / G : 0, nh = cntc - nf, m = nf < nh ? nf : nh, p = (c >> 6) & 1;
          if (i < 2 * m) { const bool full = (((i + p) & 1) == 0); i = full ? (i >> 1) : nf + (i >> 1); }
          else { const int k = m + (i - 2 * m); i = nf > nh ? k : nf + k; } }
        const long L = (long)i * G + c; if (L >= nFullU + nHalfU) return false;
        const int hf = L >= nFullU ? 1 : 0; const int nwg = hf ? nHalfU : nFullU;
        int wgid = (int)L - (hf ? nFullU : 0); { const int q = nwg / NXCD, r = nwg % NXCD, xcd = wgid % NXCD, off = wgid / NXCD; wgid = (xcd < r ? xcd * (q + 1) : r * (q + 1) + (xcd - r) * q) + off; }
        const int tix = wgid / nN, pn = wgid % nN;
        const LAS int* tb = hf ? tph : tp;
        const int ln = (int)__builtin_amdgcn_mbcnt_hi(~0u, __builtin_amdgcn_mbcnt_lo(~0u, 0u));
        const int tv0 = tb[ln], tv1 = tb[ln + 64 < NCLS ? ln + 64 : NCLS];
        const int cls = __builtin_popcountll(__ballot(ln >= 1 && tv0 <= tix)) + __builtin_popcountll(__ballot(ln + 64 < NCLS && tv1 <= tix));
        const int n = rfl(ncl[cls]), mt = hf ? (n >> 8) : tix - rfl(tb[cls]);
        const int rem = n - 256 * mt;
        u.rows = rem < 256 ? rem : 256; u.orow = 0; u.pn = pn; u.half = hf; u.split = 256;
        u.info = info + ((size_t)cls * CAP + (size_t)(256 * mt)) * 16; u.info1 = u.info;
        const int grp = cls / 28, pe = rfl(ptab[cls - 28 * grp]);
        u.b = Bt + (size_t)(8 * grp + (pe & 15)) * bExp + (size_t)pn * bTile; u.b2 = Bt + (size_t)(8 * grp + (pe >> 4)) * bExp + (size_t)pn * bTile;
        u.a = A;
        return true;
    }
};

template <class Epi, class Sched, bool INFO, bool GATHER, int AGM = 0, int QT = 0, bool PAIR = false>
__device__ __forceinline__ void gemm_phase(LAS unsigned char* lds, LAS unsigned char* linfo, const int K, const int lda, const Sched& S, const Epi& E, const int wid, const int ldb_ = 0) {
    const int lane = opaque_lane(), tid = wid * 64 + lane, wr = wid >> 2, wc = wid & 3, fr = lane & 15, fq = lane >> 4;
    const int nt = K / BK, ldb = ldb_ ? ldb_ : K;
    unsigned voffA[2][2], voffB[2]; int RA[2], CA[2];
#pragma unroll
    for (int i = 0; i < 2; ++i) { int R, C; stage_rc(tid * 16 + i * 8192, R, C); const int Rb = (R & ~31) + perm32(R & 31);
        RA[i] = R; CA[i] = C; voffB[i] = (unsigned)(Rb * ldb + C) * 2u;
        if (AGM == 1) { voffA[0][i] = (unsigned)(((C >> 4) * NROWS + R) * 32 + (C & 15) * 2); voffA[1][i] = voffA[0][i] + (unsigned)(HALF * 32); }
        else if (AGM == 2) { voffA[0][i] = (unsigned)(((C >> 3) * NROWS + R) * 16); voffA[1][i] = voffA[0][i] + (unsigned)(HALF * 16); }
        else { voffA[0][i] = (unsigned)(R * lda + C) * 2u; voffA[1][i] = (unsigned)((R + HALF) * lda + C) * 2u; } }
    const size_t kstep = (size_t)(BK * 2);
    const size_t kstepA = AGM == 1 ? (size_t)4 * NROWS * 32 : (AGM == 2 ? (size_t)8 * NROWS * 16 : kstep);
    const size_t hstep = (size_t)HALF * ldb * 2;
    const unsigned ldsw = (unsigned)wid * 1024u;
    const int aoff = lds_byte(wr * 64 + fr, fq * 8), boff = lds_byte(wc * 32 + fr, fq * 8);
#define G_SA(b, h) (((b) * 2 + (h)) * HTB)
#define G_SB(b, h) ((4 + (b) * 2 + (h)) * HTB)
#define G_STAGE(bufoff, gbase, voff) do { _Pragma("unroll") for (int _i = 0; _i < 2; ++_i) \
        __builtin_amdgcn_global_load_lds((const unsigned*)((const char*)(gbase) + (voff)[_i]), (LAS unsigned*)(lds + (bufoff) + ldsw + _i * 8192), 16, 0, 0); } while (0)
#define G_LDA(dst, b, h) do { if constexpr (QT == 1) { _Pragma("unroll") for (int m = 0; m < 4; ++m) { \
            const i32x4 _lo = *(const LAS i32x4*)(lds + G_SA(b, h) + aoff + m * 2048), _hi = *(const LAS i32x4*)(lds + G_SA(b, h) + aoff + m * 2048 + 1024); \
            dst##8[m] = __builtin_shufflevector(_lo, _hi, 0, 1, 2, 3, 4, 5, 6, 7); } } \
        else { _Pragma("unroll") for (int m = 0; m < 4; ++m) _Pragma("unroll") for (int k = 0; k < 2; ++k) dst[m][k] = *(const LAS s16x8*)(lds + G_SA(b, h) + aoff + m * 2048 + k * 1024); } } while (0)
#define G_LDB(dst, b, h) do { if constexpr (QT == 1) { _Pragma("unroll") for (int n = 0; n < 2; ++n) { \
            const i32x4 _lo = *(const LAS i32x4*)(lds + G_SB(b, h) + boff + n * 2048), _hi = *(const LAS i32x4*)(lds + G_SB(b, h) + boff + n * 2048 + 1024); \
            dst##8[n] = __builtin_shufflevector(_lo, _hi, 0, 1, 2, 3, 4, 5, 6, 7); } } \
        else { _Pragma("unroll") for (int n = 0; n < 2; ++n) _Pragma("unroll") for (int k = 0; k < 2; ++k) dst[n][k] = *(const LAS s16x8*)(lds + G_SB(b, h) + boff + n * 2048 + k * 1024); } } while (0)
#define G_MMA(ai, bj, At, Bt) do { __builtin_amdgcn_s_setprio(1); \
        if constexpr (QT == 1) { _Pragma("unroll") for (int m = 0; m < 4; ++m) _Pragma("unroll") for (int n = 0; n < 2; ++n) \
            asm volatile("v_mfma_scale_f32_16x16x128_f8f6f4 %0, %1, %2, %0, %3, %3 op_sel_hi:[0,0,0]" : "+v"(acc[ai][bj][m][n]) : "v"(Bt##8[n]), "v"(At##8[m]), "v"(sc1)); } \
        else { _Pragma("unroll") for (int m = 0; m < 4; ++m) _Pragma("unroll") for (int n = 0; n < 2; ++n) _Pragma("unroll") for (int k = 0; k < 2; ++k) { \
            if constexpr (QT == 2) acc[ai][bj][m][n] = __builtin_bit_cast(f32x4, __builtin_amdgcn_mfma_i32_16x16x64_i8(__builtin_bit_cast(i32x4, Bt[n][k]), __builtin_bit_cast(i32x4, At[m][k]), __builtin_bit_cast(i32x4, acc[ai][bj][m][n]), 0, 0, 0)); \
            else acc[ai][bj][m][n] = __builtin_amdgcn_mfma_f32_16x16x32_bf16(Bt[n][k], At[m][k], acc[ai][bj][m][n], 0, 0, 0); } } \
        __builtin_amdgcn_s_setprio(0); } while (0)
#define G_WAIT_V(n) asm volatile("s_waitcnt vmcnt(" #n ")" ::: "memory")
#define G_WAIT_L(n) asm volatile("s_waitcnt lgkmcnt(" #n ")" ::: "memory")
#define G_BAR __builtin_amdgcn_s_barrier()
#define G_SCHED __builtin_amdgcn_sched_barrier(0)
#define G_SETVOFF(buf, urows) do { _Pragma("unroll") for (int _h = 0; _h < 2; ++_h) _Pragma("unroll") for (int _i = 0; _i < 2; ++_i) { \
        const int _r = RA[_i] + _h * HALF; int _t = *(const LAS int*)(linfo + (buf) * 4096 + _r * 16); _t = (_r < (urows)) ? _t : 0; \
        voffA[_h][_i] = (unsigned)(_t * lda + CA[_i]) * 2u; } } while (0)
#define G_SETVOFF_P(buf, urows, second) do { _Pragma("unroll") for (int _h = 0; _h < 2; ++_h) _Pragma("unroll") for (int _i = 0; _i < 2; ++_i) { \
        const int _r = RA[_i] + _h * HALF; unsigned _t = *(const LAS unsigned*)(linfo + (buf) * 4096 + _r * 16); _t = (_r < (urows)) ? _t : 0u; \
        voffA[_h][_i] = (_t & 0x7fffffffu) * 1024u + (((_t >> 31) ^ (unsigned)(second)) << 9) + (unsigned)CA[_i] * 2u; } } while (0)
    Unit cur, nxt; int ui = 0, ib_cur = 0, ib_nxt = 1;
    const int tlk = nt >= 8 ? 2 : 0;
    if (!S.next(0, cur)) return;
    f32x4 acc[2][2][4][2];
#pragma unroll
    for (int a = 0; a < 2; ++a)
#pragma unroll
        for (int b = 0; b < 2; ++b)
#pragma unroll
            for (int m = 0; m < 4; ++m)
#pragma unroll
                for (int n = 0; n < 2; ++n) acc[a][b][m][n] = (f32x4){0.f, 0.f, 0.f, 0.f};
    const int sc1 = 0x7f7f7f7f;
    s16x8 At[4][2], B0[2][2], B1[2][2]; i32x8 At8[4], B08[2], B18[2];
    const char* cA = cur.a; const char* cB = cur.b; const char* cB2 = PAIR ? cur.b2 : cur.b; bool hfu = cur.half != 0;
    const int hnt = nt >> 1;
    if constexpr (INFO) {
        if (wid < 4) { const int r = wid * 64 + lane; __builtin_amdgcn_global_load_lds((const unsigned*)((r < cur.split ? cur.info : cur.info1) + r * 16), (LAS unsigned*)(linfo + wid * 1024), 16, 0, 0); }
        G_WAIT_V(0); G_BAR; asm volatile("" ::: "memory");
        if constexpr (PAIR) { G_SETVOFF_P(0, cur.rows, 0); } else if constexpr (GATHER) { G_SETVOFF(0, cur.rows); }
    }
    G_STAGE(G_SB(0, 0), cB, voffB); G_STAGE(G_SB(0, 1), cB + hstep, voffB); G_STAGE(G_SA(0, 0), cA, voffA[0]); G_STAGE(G_SA(0, 1), cA, voffA[1]);
    if (wr == 1) G_BAR;
    G_WAIT_V(2); G_BAR;
    G_STAGE(G_SB(1, 0), cB + kstep, voffB); G_STAGE(G_SA(1, 0), cA + kstepA, voffA[0]); G_STAGE(G_SB(1, 1), cB + hstep + kstep, voffB);
    G_WAIT_V(6); G_BAR;
    for (;;) {
        bool has_next = false; const char* nA = cA; const char* nB = cB; const char* nB2 = cB2;
#pragma unroll 1
        for (int t = 0; t < nt; t += 2) {
            const bool last = (t == nt - 2);
            if (t == tlk) { has_next = S.next(ui + 1, nxt); if (has_next) { nA = nxt.a; nB = nxt.b; if constexpr (PAIR) nB2 = nxt.b2; } }
            const char* a1; const char* a2; const char* b2;
            if constexpr (PAIR) { const int s1 = t + 1 >= hnt ? t + 1 - hnt : t + 1, s2 = t + 2 >= hnt ? t + 2 - hnt : t + 2;
                a1 = cA + (size_t)s1 * kstepA; a2 = last ? nA : cA + (size_t)s2 * kstepA; b2 = last ? nB : (t + 2 >= hnt ? cB2 : cB) + (size_t)s2 * kstep; }
            else { a1 = cA + (size_t)(t + 1) * kstepA; a2 = last ? nA : cA + (size_t)(t + 2) * kstepA; b2 = last ? nB : cB + (size_t)(t + 2) * kstep; }
            const char* a3 = a2 + kstepA; const char* b3 = b2 + kstep;
            if constexpr (INFO) { if (t == tlk && has_next && wid < 4) {
                const int r = wid * 64 + lane;
                __builtin_amdgcn_global_load_lds((const unsigned*)((r < nxt.split ? nxt.info : nxt.info1) + r * 16), (LAS unsigned*)(linfo + ib_nxt * 4096 + wid * 1024), 16, 0, 0); } }
            G_LDB(B0, 0, 0); G_LDB(B1, 0, 1); G_SCHED; G_LDA(At, 0, 0); G_STAGE(G_SA(1, 1), a1, voffA[1]);
            G_WAIT_V(8); G_WAIT_L(0); G_BAR; G_MMA(0, 0, At, B0); G_MMA(0, 1, At, B1); G_BAR; G_SCHED;
            if constexpr (PAIR) { if (last) { if (has_next) { G_SETVOFF_P(ib_nxt, nxt.rows, 0); } } else if (t + 2 == hnt) { G_SETVOFF_P(ib_cur, cur.rows, 1); } }
            else if constexpr (GATHER) { if (last && has_next) { G_SETVOFF(ib_nxt, nxt.rows); } }
            if (!hfu) { G_LDA(At, 0, 1); } G_STAGE(G_SB(0, 0), b2, voffB); G_STAGE(G_SB(0, 1), b2 + hstep, voffB); G_STAGE(G_SA(0, 0), a2, voffA[0]);
            G_WAIT_V(8); G_WAIT_L(0); G_BAR; if (!hfu) { G_MMA(1, 0, At, B0); G_MMA(1, 1, At, B1); } G_BAR; G_SCHED;
            G_LDB(B0, 1, 0); G_LDB(B1, 1, 1); G_SCHED; G_LDA(At, 1, 0); G_STAGE(G_SA(0, 1), a2, voffA[1]);
            G_WAIT_V(8); G_WAIT_L(0); G_BAR; G_MMA(0, 0, At, B0); G_MMA(0, 1, At, B1); G_BAR; G_SCHED;
            if (!hfu) { G_LDA(At, 1, 1); } G_STAGE(G_SB(1, 0), b3, voffB); G_STAGE(G_SB(1, 1), b3 + hstep, voffB); G_STAGE(G_SA(1, 0), a3, voffA[0]);
            G_WAIT_V(8); G_WAIT_L(0); G_BAR; if (!hfu) { G_MMA(1, 0, At, B0); G_MMA(1, 1, At, B1); } G_BAR; G_SCHED;
        }
        if (wr == 0) G_BAR;
        if constexpr (QT == 1) { asm volatile("s_nop 15\n\ts_nop 15" ::: "memory"); }
        E(acc, cur, wr, wc, fr, fq, linfo + ib_cur * 4096);
        if (!has_next) break;
#pragma unroll
        for (int a = 0; a < 2; ++a)
#pragma unroll
            for (int b = 0; b < 2; ++b)
#pragma unroll
                for (int m = 0; m < 4; ++m)
#pragma unroll
                    for (int n = 0; n < 2; ++n) acc[a][b][m][n] = (f32x4){0.f, 0.f, 0.f, 0.f};
        if constexpr (QT == 1) { asm volatile("s_nop 7" ::: "memory"); }
        cur = nxt; cA = nA; cB = nB; cB2 = nB2; hfu = cur.half != 0; ++ui; ib_cur = ib_nxt; ib_nxt = ib_nxt == 2 ? 0 : ib_nxt + 1;
        if (wr == 1) G_BAR;
    }
    G_WAIT_V(0);
    G_BAR;
#undef G_SA
#undef G_SB
#undef G_STAGE
#undef G_LDA
#undef G_LDB
#undef G_MMA
#undef G_WAIT_V
#undef G_WAIT_L
#undef G_BAR
#undef G_SCHED
#undef G_SETVOFF
#undef G_SETVOFF_P
}

typedef f32x4 Acc[2][2][4][2];
__device__ __forceinline__ u32x4 pack8(const f32x4 a, const f32x4 b) { u32x4 w; w.x = cvt_pk_bf16(a[0], a[1]); w.y = cvt_pk_bf16(a[2], a[3]); w.z = cvt_pk_bf16(b[0], b[1]); w.w = cvt_pk_bf16(b[2], b[3]); return w; }
__device__ __forceinline__ void unpack8(const u32x4 w, f32x4& a, f32x4& b) { a = (f32x4){bf_lo(w.x), bf_hi(w.x), bf_lo(w.y), bf_hi(w.y)}; b = (f32x4){bf_lo(w.z), bf_hi(w.z), bf_lo(w.w), bf_hi(w.w)}; }

struct EpiU {
    bf16_t* O; const LAS float* rtab; const LAS float* ctab; int gmaj;
    __device__ __forceinline__ void operator()(const Acc& acc, const Unit& u, int wr, int wc, int fr, int fq, LAS unsigned char*) const {
        const int row0 = u.orow + wr * 64 + fr, col0 = u.pn * 256 + wc * 32 + 8 * fq;
        const LAS float* rt = rtab + u.seq * 256 + wr * 64 + fr;
        f32x4 sc[2][2];
#pragma unroll
        for (int bj = 0; bj < 2; ++bj) { sc[bj][0] = *(const LAS f32x4*)(ctab + col0 + bj * HALF); sc[bj][1] = *(const LAS f32x4*)(ctab + col0 + bj * HALF + 4); }
#pragma unroll
        for (int ai = 0; ai < 2; ++ai)
#pragma unroll
            for (int m = 0; m < 4; ++m) { const int r = row0 + ai * HALF + m * 16; const float s = rt[ai * HALF + m * 16];
#pragma unroll
                for (int bj = 0; bj < 2; ++bj) { const int col = col0 + bj * HALF;
                    bf16_t* p = gmaj ? O + ((size_t)(col >> 4) * NROWS + r) * 16 + (col & 15) : O + (size_t)r * D + col;
                    const f32x4 v0 = __builtin_convertvector(__builtin_bit_cast(i32x4, acc[ai][bj][m][0]), f32x4) * sc[bj][0] * s, v1 = __builtin_convertvector(__builtin_bit_cast(i32x4, acc[ai][bj][m][1]), f32x4) * sc[bj][1] * s;
                    *(u32x4*)p = pack8(v0, v1); } }
    }
};
struct EpiGlu {
    bf16_t* H; unsigned char* H8; float sc;
    __device__ __forceinline__ void operator()(const Acc& acc, const Unit& u, int wr, int wc, int fr, int fq, LAS unsigned char*) const {
        const int row0 = u.orow + wr * 64 + fr, col0 = u.pn * 128 + wc * 32 + 8 * fq;
        u32x4 hv[2][4];
#pragma unroll
        for (int ai = 0; ai < 2; ++ai)
#pragma unroll
            for (int m = 0; m < 4; ++m) hv[ai][m] = *(const u32x4*)(H + (size_t)(row0 + ai * HALF + m * 16) * D + col0);
#pragma unroll
        for (int ai = 0; ai < 2; ++ai)
#pragma unroll
            for (int m = 0; m < 4; ++m) { bf16_t* p = H + (size_t)(row0 + ai * HALF + m * 16) * D + col0;
                f32x4 h0, h1; unpack8(hv[ai][m], h0, h1);
                const f32x4 v0 = acc[ai][0][m][0] * sc, v1 = acc[ai][0][m][1] * sc, g0 = acc[ai][1][m][0] * sc, g1 = acc[ai][1][m][1] * sc;
#pragma unroll
                for (int j = 0; j < 4; ++j) { h0[j] += v0[j] * sigmoid_f(g0[j]); h1[j] += v1[j] * sigmoid_f(g1[j]); }
                *(u32x4*)p = pack8(h0, h1);
                *(u32x2*)(H8 + (size_t)(row0 + ai * HALF + m * 16) * D + col0) = (u32x2){cvt_pk4_fp8(h0[0], h0[1], h0[2], h0[3]), cvt_pk4_fp8(h1[0], h1[1], h1[2], h1[3])}; }
    }
};
struct EpiGrp {
    bf16_t* H; const float* scale; unsigned char* H8;
    __device__ __forceinline__ void operator()(const Acc& acc, const Unit& u, int wr, int wc, int fr, int fq, LAS unsigned char*) const {
        const int row0 = u.orow + wr * 64 + fr, col0 = u.pn * 256 + wc * 32 + 8 * fq;
        f32x4 sc[2][2];
#pragma unroll
        for (int bj = 0; bj < 2; ++bj) { sc[bj][0] = *(const f32x4*)(scale + col0 + bj * HALF); sc[bj][1] = *(const f32x4*)(scale + col0 + bj * HALF + 4); }
#pragma unroll
        for (int ai = 0; ai < 2; ++ai) {
            u32x4 hv[4][2];
#pragma unroll
            for (int m = 0; m < 4; ++m)
#pragma unroll
                for (int bj = 0; bj < 2; ++bj) hv[m][bj] = *(const u32x4*)(H + (size_t)(row0 + ai * HALF + m * 16) * D + col0 + bj * HALF);
#pragma unroll
            for (int m = 0; m < 4; ++m) { bf16_t* p = H + (size_t)(row0 + ai * HALF + m * 16) * D + col0;
#pragma unroll
                for (int bj = 0; bj < 2; ++bj) { f32x4 h0, h1; unpack8(hv[m][bj], h0, h1);
                    h0 += acc[ai][bj][m][0] * sc[bj][0]; h1 += acc[ai][bj][m][1] * sc[bj][1];
                    *(u32x4*)(p + bj * HALF) = pack8(h0, h1);
                    *(u32x2*)(H8 + (size_t)(row0 + ai * HALF + m * 16) * D + col0 + bj * HALF) = (u32x2){cvt_pk4_fp8(h0[0], h0[1], h0[2], h0[3]), cvt_pk4_fp8(h1[0], h1[1], h1[2], h1[3])}; } }
        }
    }
};
struct EpiGU {
    bf16_t* HID;
    __device__ __forceinline__ void operator()(const Acc& acc, const Unit& u, int wr, int wc, int fr, int fq, LAS unsigned char* linfo) const {
        const int col0 = u.pn * 128 + wc * 32 + 8 * fq;
#pragma unroll
        for (int ai = 0; ai < 2; ++ai)
#pragma unroll
            for (int m = 0; m < 4; ++m) { const int rl = ai * HALF + wr * 64 + m * 16 + fr;
                const f32x4 inf = *(const LAS f32x4*)(linfo + rl * 16); const float w = inf[1], rs = inf[2] * (1.0f / 32.0f);
                f32x4 o0, o1;
#pragma unroll
                for (int j = 0; j < 4; ++j) { const float ga = acc[ai][0][m][0][j] * rs, gb = acc[ai][0][m][1][j] * rs;
                    o0[j] = __builtin_amdgcn_fmed3f(w * ga * sigmoid_f(ga) * (acc[ai][1][m][0][j] * rs), -25.f, 25.f);
                    o1[j] = __builtin_amdgcn_fmed3f(w * gb * sigmoid_f(gb) * (acc[ai][1][m][1][j] * rs), -25.f, 25.f); }
                if (rl < u.rows) *(u32x2*)((unsigned char*)HID + ((size_t)__float_as_int(inf[0]) * 2 + (rl >= u.split ? 1 : 0)) * DE + col0) = (u32x2){cvt_pk4_fp8(o0[0] * 16.f, o0[1] * 16.f, o0[2] * 16.f, o0[3] * 16.f), cvt_pk4_fp8(o1[0] * 16.f, o1[1] * 16.f, o1[2] * 16.f, o1[3] * 16.f)}; }
    }
};
template <bool SS>
struct EpiAdd {
    bf16_t* H; float* SSP; float ascale; unsigned char* HI8;
    __device__ __forceinline__ void operator()(const Acc& acc, const Unit& u, int wr, int wc, int fr, int fq, LAS unsigned char* linfo) const {
        const int col0 = u.pn * 256 + wc * 32 + 8 * fq;
        u32x4 hv[2][4][2]; int tok[2][4];
#pragma unroll
        for (int ai = 0; ai < 2; ++ai)
#pragma unroll
            for (int m = 0; m < 4; ++m) { const int rl = ai * HALF + wr * 64 + m * 16 + fr; tok[ai][m] = *(const LAS int*)(linfo + rl * 16) & 0x7fffffff;
                hv[ai][m][0] = (u32x4){0u, 0u, 0u, 0u}; hv[ai][m][1] = hv[ai][m][0];
                if (rl < u.rows) { const bf16_t* p = H + (size_t)tok[ai][m] * D + col0; hv[ai][m][0] = *(const u32x4*)p; hv[ai][m][1] = *(const u32x4*)(p + HALF); } }
#pragma unroll
        for (int ai = 0; ai < 2; ++ai)
#pragma unroll
            for (int m = 0; m < 4; ++m) { const int rl = ai * HALF + wr * 64 + m * 16 + fr; const bool valid = rl < u.rows; float ss = 0.f;
                if (SS) tok[ai][m] = *(const LAS int*)(linfo + rl * 16) & 0x7fffffff;
#pragma unroll
                for (int bj = 0; bj < 2; ++bj) { f32x4 h0, h1; unpack8(hv[ai][m][bj], h0, h1); h0 += acc[ai][bj][m][0] * ascale; h1 += acc[ai][bj][m][1] * ascale;
                    if (SS) ss += (h0[0] * h0[0] + h0[1] * h0[1]) + (h0[2] * h0[2] + h0[3] * h0[3]) + (h1[0] * h1[0] + h1[1] * h1[1]) + (h1[2] * h1[2] + h1[3] * h1[3]);
                    if (valid) { *(u32x4*)(H + (size_t)tok[ai][m] * D + col0 + bj * HALF) = pack8(h0, h1);
                        if (SS && HI8) { const float qs = *(const LAS float*)(linfo + rl * 16 + 8) * (127.0f / QCLIP); *(u32x2*)(HI8 + (size_t)tok[ai][m] * D + col0 + bj * HALF) = pack8_i8(h0 * qs, h1 * qs); } } }
                if (SS) { ss += __shfl_xor(ss, 16); ss += __shfl_xor(ss, 32); if (valid && fq == 0) SSP[(size_t)tok[ai][m] * 32 + u.pn * 4 + wc] = ss; } }
    }
};
struct EpiDn {
    bf16_t* Y; unsigned* AM = nullptr;
    __device__ __forceinline__ void operator()(const Acc& acc, const Unit& u, int wr, int wc, int fr, int fq, LAS unsigned char*) const {
        const int col0 = u.pn * 256 + wc * 32 + 8 * fq;
#pragma unroll
        for (int ai = 0; ai < 2; ++ai)
#pragma unroll
            for (int m = 0; m < 4; ++m) { const int rl = ai * HALF + wr * 64 + m * 16 + fr;
                if (rl < u.rows) { bf16_t* p = Y + (size_t)(u.orow + rl) * D + col0;
#pragma unroll
                    for (int bj = 0; bj < 2; ++bj) *(u32x4*)(p + bj * HALF) = pack8(acc[ai][bj][m][0], acc[ai][bj][m][1]); }
                if (AM) { f32x4 mx = __builtin_elementwise_max(__builtin_elementwise_max(__builtin_elementwise_abs(acc[ai][0][m][0]), __builtin_elementwise_abs(acc[ai][0][m][1])),
                                                            __builtin_elementwise_max(__builtin_elementwise_abs(acc[ai][1][m][0]), __builtin_elementwise_abs(acc[ai][1][m][1])));
                    float mv = fmaxf(fmaxf(mx[0], mx[1]), fmaxf(mx[2], mx[3])); mv = fmaxf(mv, __shfl_xor(mv, 16)); mv = fmaxf(mv, __shfl_xor(mv, 32));
                    if (fq == 0 && rl < u.rows) atomicMax(AM + u.orow + rl, __float_as_uint(mv)); } }
    }
};
}


template <int KIND>
__device__ __forceinline__ void meta_gemm(LAS unsigned char* lds, const bf16_t* W, int K, int wrow0, int wrow1, const bf16_t* A, bf16_t* O, const float* aux, int cb, int wave, int lane, int gmaj = 0, unsigned char* H8 = nullptr, const float* ssp = nullptr) {
    const int m = lane & 15, q = lane >> 4, kw = K >> 3, nks = kw >> 5;
    f32x4 acc = (f32x4){0.f, 0.f, 0.f, 0.f}, acc2 = acc;
    const bf16_t* wp = W + (size_t)(wrow0 + m) * K + kw * wave + 8 * q;
    const bf16_t* wp2 = W + (size_t)(wrow1 + m) * K + kw * wave + 8 * q;
    const bf16_t* ap = A + (size_t)m * D + kw * wave + 8 * q;
#pragma unroll
    for (int ks = 0; ks < 8; ++ks) if (ks < nks) {
        const int kk = kw * wave + 32 * ks + 8 * q;
        union { u32x4 u; s16x8 s; } a, b, a2; a.u = *(const u32x4*)(wp + 32 * ks);
        b.u = (KIND == 1) ? *(const u32x4*)(A + ((size_t)(kk >> 4) * 16 + m) * 16 + (kk & 15)) : *(const u32x4*)(ap + 32 * ks);
        acc = __builtin_amdgcn_mfma_f32_16x16x32_bf16(a.s, b.s, acc, 0, 0, 0);
        if (KIND == 1) { a2.u = *(const u32x4*)(wp2 + 32 * ks); acc2 = __builtin_amdgcn_mfma_f32_16x16x32_bf16(a2.s, b.s, acc2, 0, 0, 0); }
    }
    LAS f32x4* red = (LAS f32x4*)lds;
    red[wave * 64 + lane] = acc; if (KIND == 1) red[512 + wave * 64 + lane] = acc2;
    __syncthreads();
    if (wave == 0) {
        f32x4 v = red[lane], g = (f32x4){0.f, 0.f, 0.f, 0.f};
#pragma unroll
        for (int w = 1; w < 8; ++w) v += red[w * 64 + lane];
        if (KIND == 1) { g = red[512 + lane];
#pragma unroll
            for (int w = 1; w < 8; ++w) g += red[512 + w * 64 + lane]; }
        const int col = 16 * cb + 4 * q; bf16_t* op = O + (size_t)(NREAL + m) * D + col;
        if (KIND == 0) { float s;
            if (ssp) { const f32x4* pp = (const f32x4*)(ssp + (size_t)(NREAL + m) * 32); f32x4 a = pp[0];
#pragma unroll
                for (int k = 1; k < 8; ++k) a += pp[k];
                s = rsqrtf(((a[0] + a[1]) + (a[2] + a[3])) * (1.0f / D) + RMS_EPS); }
            else s = aux[NREAL + m];
            bf16_t* up = gmaj ? O + ((size_t)cb * NROWS + NREAL + m) * 16 + 4 * q : op;
            *(u32x2*)up = (u32x2){cvt_pk_bf16(v[0] * s, v[1] * s), cvt_pk_bf16(v[2] * s, v[3] * s)}; }
        else { const u32x2 hv = *(const u32x2*)op; f32x4 h = (f32x4){bf_lo(hv.x), bf_hi(hv.x), bf_lo(hv.y), bf_hi(hv.y)};
            if (KIND == 1) {
#pragma unroll
                for (int i = 0; i < 4; ++i) h[i] += v[i] * sigmoid_f(g[i]); }
            else h += v * *(const f32x4*)(aux + col);
            *(u32x2*)op = (u32x2){cvt_pk_bf16(h[0], h[1]), cvt_pk_bf16(h[2], h[3])};
            *(unsigned*)(H8 + (size_t)(NREAL + m) * D + col) = cvt_pk4_fp8(h[0], h[1], h[2], h[3]); }
    }
    __syncthreads();
}
struct Params { const float* in[25]; float* out; unsigned char* ws; int ph_lo, ph_hi; };
enum { I_X = 0, I_META, I_NMIX, I_NFFN, I_NFIN, I_S5WIN, I_ARE, I_AIM, I_LOGDT, I_BRE, I_BIM, I_CRE, I_CIM, I_S5D, I_S5GLU, I_PWIN, I_PGRP, I_PSCALE,
       I_WC, I_BC, I_WF, I_BF, I_WG, I_WU, I_WD };

struct ConvDesc { const float* w; const float* gain; unsigned char* dst; unsigned char* dst2; int ldw, Kd, kind, off, n0, esz; float wscale; };
__device__ __forceinline__ void conv_load(const ConvDesc& d, f32x4 (&v)[16], int lane) {
#pragma unroll
    for (int it = 0; it < 16; ++it) { const int kk = 4 * it + (lane >> 4), n4 = (lane & 15) * 4; v[it] = *(const f32x4*)(d.w + (size_t)kk * d.ldw + n4); }
}
__device__ __forceinline__ void conv_store(const ConvDesc& d, const f32x4 (&v)[16], LAS float* scr, int lane) {
    const int c = lane & 7;
    f32x4 g0 = (f32x4){1.f, 1.f, 1.f, 1.f}, g1 = g0;
    if (d.gain) { g0 = *(const f32x4*)(d.gain + 8 * c); g1 = *(const f32x4*)(d.gain + 8 * c + 4); }
#pragma unroll
    for (int it = 0; it < 16; ++it) { const int kk = 4 * it + (lane >> 4), n4 = (lane & 15) * 4;
        LAS float* s = scr + kk * 65 + n4; s[0] = v[it][0]; s[1] = v[it][1]; s[2] = v[it][2]; s[3] = v[it][3]; }
    LDS_WAIT();
#pragma unroll
    for (int j = 0; j < 8; ++j) { const int nl = (lane >> 3) + 8 * j; const LAS float* s = scr + (8 * c) * 65 + nl;
        const float x0 = s[0] * g0[0], x1 = s[65] * g0[1], x2 = s[130] * g0[2], x3 = s[195] * g0[3], x4 = s[260] * g1[0], x5 = s[325] * g1[1], x6 = s[390] * g1[2], x7 = s[455] * g1[3];
        const int n = d.n0 + nl;
        const int row = d.kind == 0 ? n + d.off : (d.kind == 1 ? ((n & 2047) >> 7) * 256 + (n >> 11) * 128 + (n & 127) : (n >> 7) * 256 + d.off + (n & 127));
        if (d.esz == 2) { u32x4 o; o.x = cvt_pk_bf16(x0, x1); o.y = cvt_pk_bf16(x2, x3); o.z = cvt_pk_bf16(x4, x5); o.w = cvt_pk_bf16(x6, x7); *(u32x4*)(d.dst + ((size_t)row * d.Kd + 8 * c) * 2) = o;
            if (d.dst2) *(u32x2*)(d.dst2 + (size_t)row * d.Kd + 8 * c) = (u32x2){cvt_pk4_fp8(x0 * 32.f, x1 * 32.f, x2 * 32.f, x3 * 32.f), cvt_pk4_fp8(x4 * 32.f, x5 * 32.f, x6 * 32.f, x7 * 32.f)}; }
        else { const float ws_ = d.wscale; *(u32x2*)(d.dst + (size_t)row * d.Kd + 8 * c) = (u32x2){cvt_pk4_fp8(x0 * ws_, x1 * ws_, x2 * ws_, x3 * ws_), cvt_pk4_fp8(x4 * ws_, x5 * ws_, x6 * ws_, x7 * ws_)}; } }
    LDS_WAIT();
}
__device__ __forceinline__ void conv_store_i8(const ConvDesc& d, const f32x4 (&v)[16], LAS float* scr, int lane, const unsigned* am) {
    const int c = lane & 7;
    f32x4 g0 = (f32x4){1.f, 1.f, 1.f, 1.f}, g1 = g0;
    if (d.gain) { g0 = *(const f32x4*)(d.gain + 8 * c); g1 = *(const f32x4*)(d.gain + 8 * c + 4); }
#pragma unroll
    for (int it = 0; it < 16; ++it) { const int kk = 4 * it + (lane >> 4), n4 = (lane & 15) * 4;
        LAS float* s = scr + kk * 65 + n4; s[0] = v[it][0]; s[1] = v[it][1]; s[2] = v[it][2]; s[3] = v[it][3]; }
    LDS_WAIT();
#pragma unroll
    for (int j = 0; j < 8; ++j) { const int nl = (lane >> 3) + 8 * j; const LAS float* s = scr + (8 * c) * 65 + nl; const int n = d.n0 + nl;
        const float qs = 127.0f / fmaxf(__uint_as_float(am[n]), 1e-30f);
        const f32x4 a = (f32x4){s[0] * g0[0], s[65] * g0[1], s[130] * g0[2], s[195] * g0[3]} * qs, b = (f32x4){s[260] * g1[0], s[325] * g1[1], s[390] * g1[2], s[455] * g1[3]} * qs;
        *(u32x2*)(d.dst + (size_t)n * d.Kd + 8 * c) = pack8_i8(a, b); }
    LDS_WAIT();
}
constexpr int CV_WIN = 2 * 1024, CV_GLU = 2 * 2048, CV_GRP = 8 * 64, CV_GT = 128 * 256, CV_UP = 128 * 256, CV_DN = 128 * 256;
constexpr int CV_ITEMS = CV_WIN + CV_GLU + CV_GRP + CV_GT + CV_UP + CV_DN;
__device__ __forceinline__ bool conv_decode(const Params& P, int it, ConvDesc& d) {
    if (it >= CV_ITEMS) return false;
    unsigned char* ws = P.ws; int r = it; const float* W; const float* gain = nullptr; bf16_t* dst; unsigned char* dst2 = nullptr; int ldw, Kd, kind = 0, off = 0, kb, nb, esz = 2; float wscale = 1.0f;
    if (r < CV_WIN) { const int i = (r >> 10) * 2, rr = r & 1023; kb = rr >> 5; nb = rr & 31;
        W = (i & 1) ? P.in[I_PWIN] + (size_t)(i >> 1) * D * D : P.in[I_S5WIN] + (size_t)(i >> 1) * D * D; ldw = D; gain = P.in[I_NMIX] + i * D; dst = (bf16_t*)(ws + WS_WIN) + (size_t)i * D * D; Kd = D; }
    else if ((r -= CV_WIN) < CV_GLU) { const int j = r >> 11, rr = r & 2047; kb = rr >> 6; nb = rr & 63;
        W = P.in[I_S5GLU] + (size_t)j * D * 4096; ldw = 4096; dst = (bf16_t*)(ws + WS_GLU) + (size_t)j * 4096 * D; dst2 = ws + WS_GLU8 + (size_t)j * 4096 * D; Kd = D; kind = 1; }
    else if ((r -= CV_GLU) < CV_GRP) { const int m = r >> 6, rr = r & 63; kb = rr >> 3; nb = rr & 7;
        W = P.in[I_PGRP] + (size_t)m * 512 * 512; ldw = 512; dst = (bf16_t*)(ws + WS_GRP) + (size_t)(m >> 2) * D * 512; Kd = 512; off = (m & 3) * 512; }
    else if ((r -= CV_GRP) < CV_GT) { const int m = r >> 8, rr = r & 255; kb = rr >> 3; nb = rr & 7;
        W = P.in[I_WG] + (size_t)m * D * DE; ldw = DE; gain = P.in[I_NFFN] + (m >> 5) * D; dst = (bf16_t*)(ws + WS_GU + (size_t)m * 1024 * D); Kd = D; kind = 2; esz = 1; wscale = 32.0f; }
    else if ((r -= CV_GT) < CV_UP) { const int m = r >> 8, rr = r & 255; kb = rr >> 3; nb = rr & 7;
        W = P.in[I_WU] + (size_t)m * D * DE; ldw = DE; gain = P.in[I_NFFN] + (m >> 5) * D; dst = (bf16_t*)(ws + WS_GU + (size_t)m * 1024 * D); Kd = D; kind = 2; off = 128; esz = 1; wscale = 32.0f; }
    else { r -= CV_UP; const int m = r >> 8, rr = r & 255; kb = rr >> 5; nb = rr & 31;
        W = P.in[I_WD] + (size_t)m * DE * D; ldw = D; dst = (bf16_t*)(ws + WS_DN + (size_t)m * D * DE); Kd = DE; esz = 1; wscale = 16.0f; }
    d.w = W + (size_t)(kb * 64) * ldw + nb * 64; d.gain = gain ? gain + kb * 64 : nullptr; d.dst = (unsigned char*)dst + (size_t)(kb * 64) * esz; d.dst2 = dst2 ? dst2 + kb * 64 : nullptr; d.esz = esz; d.wscale = wscale; d.ldw = ldw; d.Kd = Kd; d.kind = kind; d.off = off; d.n0 = nb * 64;
    return true;
}

__device__ __forceinline__ void s5_tables(const Params& P, LAS unsigned char* lds, int wave, int lane);
__device__ __forceinline__ void phase0(const Params& P, LAS unsigned char* lds, int wave, int lane) {
    unsigned char* ws = P.ws;
    const int G = gridDim.x, gw = blockIdx.x * NWAVES + wave, NGW = G * NWAVES;
    const int gt = blockIdx.x * NTHR + wave * 64 + lane, NGT = G * NTHR;
    {
        bf16_t* H = (bf16_t*)(ws + WS_H); float* RS = (float*)(ws + WS_RSTD);
        float* RQ = (float*)(ws + WS_RQ); unsigned char* HI8 = ws + WS_HI8;
        for (int row = gw; row < NROWS; row += NGW) {
            const float* src = row < NREAL ? P.in[I_X] + (size_t)row * D : P.in[I_META] + (size_t)(row - NREAL) * D;
            float ss = 0.f; f32x4 va[4], vb[4];
#pragma unroll
            for (int j = 0; j < 4; ++j) { const int c = lane * 8 + 512 * j; const f32x4 a = *(const f32x4*)(src + c), b = *(const f32x4*)(src + c + 4); va[j] = a; vb[j] = b;
                ss += (a[0] * a[0] + a[1] * a[1]) + (a[2] * a[2] + a[3] * a[3]) + (b[0] * b[0] + b[1] * b[1]) + (b[2] * b[2] + b[3] * b[3]);
                *(u32x4*)(H + (size_t)row * D + c) = gm::pack8(a, b); }
            ss = wave_sum(ss);
            const float rs = rsqrtf(ss * (1.0f / D) + RMS_EPS), qs = rs * (127.0f / QCLIP);
            if (lane == 0) { RS[row] = rs; RQ[row] = rs; }
#pragma unroll
            for (int j = 0; j < 4; ++j) *(u32x2*)(HI8 + (size_t)row * D + lane * 8 + 512 * j) = pack8_i8(va[j] * qs, vb[j] * qs);
        }
    }
    {
        u32x4* RT = (u32x4*)(ws + WS_RT);
        for (int id = gt; id < 4 * 64 * 3 * 64; id += NGT) {
            const int ln = id & 63, nb = (id >> 6) % 3, ks = (id / 192) & 63, i = id / (192 * 64);
            const int col = 16 * nb + (ln & 15), kb = 32 * ks + 8 * (ln >> 4);
            float v[8];
#pragma unroll
            for (int jj = 0; jj < 8; ++jj) { const int k = kb + jj; float w = 0.f;
                if (col < 4) w = P.in[I_WC][((size_t)i * D + k) * 4 + col]; else if (col < 36) w = P.in[I_WF][((size_t)i * D + k) * 32 + (col - 4)];
                v[jj] = w * P.in[I_NFFN][i * D + k]; }
            u32x4 o; o.x = cvt_pk_bf16(v[0], v[1]); o.y = cvt_pk_bf16(v[2], v[3]); o.z = cvt_pk_bf16(v[4], v[5]); o.w = cvt_pk_bf16(v[6], v[7]);
            RT[id] = o;
        }
    }
    {
        bf16_t* WO = (bf16_t*)(ws + WS_WINO);
        for (int id = gt; id < 2 * D * (D / 8); id += NGT) {
            const int n8 = id & 255, k = (id >> 8) & 2047, j = id >> 19;
            const float* src = P.in[I_PWIN] + ((size_t)j * D + k) * D + n8 * 8; const float gs = P.in[I_NMIX][(2 * j + 1) * D + k];
            const f32x4 a = *(const f32x4*)src * gs, b = *(const f32x4*)(src + 4) * gs;
            *(u32x4*)(WO + ((size_t)j * D + k) * D + n8 * 8) = gm::pack8(a, b);
        }
    }
    {
        unsigned* AM = (unsigned*)ws + CW_AM; const int tid = wave * 64 + lane;
        for (int it = blockIdx.x; it < 64; it += G) {
            const int jl = it >> 5, kb = it & 31, i = 2 * jl; const float* W = P.in[I_S5WIN] + (size_t)jl * D * D + (size_t)kb * 64 * D + tid * 4; const float* gp = P.in[I_NMIX] + i * D + kb * 64;
            f32x4 mx = (f32x4){0.f, 0.f, 0.f, 0.f};
#pragma unroll 8
            for (int k = 0; k < 64; ++k) { const f32x4 v = *(const f32x4*)(W + (size_t)k * D) * gp[k]; mx = __builtin_elementwise_max(mx, __builtin_elementwise_abs(v)); }
#pragma unroll
            for (int c = 0; c < 4; ++c) atomicMax(AM + i * D + tid * 4 + c, __float_as_uint(mx[c]));
        }
    }
    if (blockIdx.x & 1) s5_tables(P, lds, wave, lane);
    {
        LAS float* scr = (LAS float*)(lds + LDS_STAGE) + wave * (64 * 65);
        ConvDesc da, db; f32x4 va[16], vb[16];
        int it = gw; bool ha = conv_decode(P, it, da);
        if (ha) conv_load(da, va, lane);
        while (ha) {
            const bool hb = conv_decode(P, it + NGW, db);
            if (hb) conv_load(db, vb, lane);
            conv_store(da, va, scr, lane);
            if (!hb) break;
            it += 2 * NGW;
            ha = conv_decode(P, it, da);
            if (ha) conv_load(da, va, lane);
            conv_store(db, vb, scr, lane);
        }
    }
    if (!(blockIdx.x & 1)) s5_tables(P, lds, wave, opaque_lane());
}

__device__ __forceinline__ void s5_tables(const Params& P, LAS unsigned char* lds, int wave, int lane) {
    unsigned char* ws = P.ws; const int tid = wave * 64 + lane;
    LAS float* pwr = (LAS float*)lds; LAS float* pwi = pwr + 576; LAS float* bbr = pwi + 576; LAS float* bbi = bbr + 1024;
    LAS float* ccr = bbi + 1024; LAS float* cci = ccr + 1024; LAS float* Kt = cci + 1024; LAS float* dk = Kt + 2048;
    for (int bj = blockIdx.x; bj < 2 * NG; bj += gridDim.x) {
        const int j = bj >> 7, g = bj & 127;
        __syncthreads();
        if (tid < 64) {
            const int s = tid;
            const double dt = exp((double)P.in[I_LOGDT][j * NG + g]);
            const double lr = (double)P.in[I_ARE][(j * NG + g) * NST + s], li = (double)P.in[I_AIM][(j * NG + g) * NST + s];
            const double mag = exp(lr * dt), abr = mag * cos(li * dt), abi = mag * sin(li * dt);
            const double den = lr * lr + li * li, nr = abr - 1.0, ni = abi;
            const double cr = (nr * lr + ni * li) / den, ci = (ni * lr - nr * li) / den;
            double pr = 1.0, pi = 0.0;
            for (int k = 0; k <= 8; ++k) { pwr[k * 64 + s] = (float)pr; pwi[k * 64 + s] = (float)pi; const double t = pr * abr - pi * abi; pi = pr * abi + pi * abr; pr = t; }
            const double magL = exp(lr * dt * CL), alr = magL * cos(li * dt * CL), ali = magL * sin(li * dt * CL);
            float* TA = (float*)(ws + WS_S5A); float* TL = (float*)(ws + WS_S5L);
            TA[((j * NG + g) * 2 + 0) * NST + s] = pwr[8 * 64 + s]; TA[((j * NG + g) * 2 + 1) * NST + s] = pwi[8 * 64 + s];
            TL[((j * NG + g) * 2 + 0) * NST + s] = (float)alr; TL[((j * NG + g) * 2 + 1) * NST + s] = (float)ali;
            for (int h = 0; h < 16; ++h) {
                const double br = (double)P.in[I_BRE][((size_t)(j * NG + g) * NST + s) * 16 + h], bi = (double)P.in[I_BIM][((size_t)(j * NG + g) * NST + s) * 16 + h];
                bbr[s * 16 + h] = (float)(cr * br - ci * bi); bbi[s * 16 + h] = (float)(cr * bi + ci * br); }
        }
        if (tid >= 64 && tid < 80) dk[tid - 64] = P.in[I_S5D][(size_t)j * D + 16 * g + tid - 64];
        for (int e = tid; e < 1024; e += NTHR) { ccr[e] = P.in[I_CRE][(size_t)(j * NG + g) * 1024 + e]; cci[e] = P.in[I_CIM][(size_t)(j * NG + g) * 1024 + e]; }
        __syncthreads();
        for (int e = tid; e < 2048; e += NTHR) {
            const int tau = e >> 8, h = (e >> 4) & 15, hp = e & 15; float acc = 0.f;
            for (int s = 0; s < 64; ++s) { const float c_r = ccr[h * 64 + s], c_i = cci[h * 64 + s], p_r = pwr[tau * 64 + s], p_i = pwi[tau * 64 + s];
                const float m_r = c_r * p_r - c_i * p_i, m_i = c_r * p_i + c_i * p_r; acc += m_r * bbr[s * 16 + hp] - m_i * bbi[s * 16 + hp]; }
            Kt[e] = acc;
        }
        __syncthreads();
        u32x4* T = (u32x4*)(ws + WS_S5T) + (size_t)(j * NG + g) * 3 * 2048;
        for (int f = tid; f < 3 * 2048; f += NTHR) {
            const int ln = f & 63, ks = (f >> 6) & 3, rb = (f >> 8) & 7, mat = f >> 11, m = ln & 15, qa = ln >> 4;
            float v[8];
#pragma unroll
            for (int jj = 0; jj < 8; ++jj) {
                float val;
                if (mat == 0) { const int part = rb >> 2, s = 16 * (rb & 3) + m, i = 2 * ks + (qa >> 1), hp = 8 * (qa & 1) + jj;
                    const float p_r = pwr[(7 - i) * 64 + s], p_i = pwi[(7 - i) * 64 + s], b_r = bbr[s * 16 + hp], b_i = bbi[s * 16 + hp];
                    val = part ? (p_r * b_i + p_i * b_r) : (p_r * b_r - p_i * b_i); }
                else if (mat == 1) { const int jstep = rb, h = m, rbs = 2 * ks + (jj >> 2), part = rbs >> 2, s = 16 * (rbs & 3) + 4 * qa + (jj & 3);
                    const float c_r = ccr[h * 64 + s], c_i = cci[h * 64 + s], p_r = pwr[(jstep + 1) * 64 + s], p_i = pwi[(jstep + 1) * 64 + s];
                    val = part ? -(c_r * p_i + c_i * p_r) : (c_r * p_r - c_i * p_i); }
                else { const int jstep = rb, h = m, i = 2 * ks + (qa >> 1), hp = 8 * (qa & 1) + jj;
                    val = (i <= jstep) ? Kt[((jstep - i) * 16 + h) * 16 + hp] + ((i == jstep && h == hp) ? dk[h] : 0.f) : 0.f; }
                v[jj] = val;
            }
            T[f] = (u32x4){cvt_pk_bf16(v[0], v[1]), cvt_pk_bf16(v[2], v[3]), cvt_pk_bf16(v[4], v[5]), cvt_pk_bf16(v[6], v[7])};
        }
    }
    __syncthreads();
}

template <int PASS>
__device__ __forceinline__ void s5_chunk(unsigned char* ws, int j, int g, int c, LAS unsigned char* lds, int lane, f32x4 (&xr)[4], f32x4 (&xi)[4]) {
    const bf16_t* U = (const bf16_t*)(ws + WS_U); bf16_t* Z = (bf16_t*)(ws + WS_Z); float* SL = (float*)(ws + WS_SLOC);
    const int n = lane & 15, q = lane >> 4;
    const int t0 = c < NCH ? NMETA + c * CL : 0, nblk = c < NCH ? CL / 8 : NMETA / 8;
    const LAS float* a8 = (const LAS float*)(lds + 3 * 32768);
    const bf16_t* ub = U + (size_t)g * NROWS * 16 + 8 * (q & 1);
    bf16_t* zb = (bf16_t*)(ws + WS_ZM) + (size_t)g * 256 + 4 * q;
    unsigned char* z8b = ws + WS_Z8 + (size_t)g * NROWS * 16 + 4 * q;
    auto ldu = [&](int tt) -> u32x4 { tt = tt < TT ? tt : TT - 1; return *(const u32x4*)(ub + (size_t)rowidx(n, tt) * 16); };
#define S5_FRAG(mat, rb, ks) (*(const LAS s16x8*)(lds + ((((mat) * 8 + (rb)) * 4 + (ks)) * 64 + lane) * 16))
    constexpr int G0 = PASS == 2 ? 0 : 8;
    s16x8 fa[2][8];
    auto loadg = [&](const int gi, s16x8 (&buf)[8]) {
        if (gi < 8) { const int hh = gi >> 2, ks = gi & 3;
#pragma unroll
            for (int r4 = 0; r4 < 4; ++r4) { buf[r4] = S5_FRAG(1, 4 * hh + r4, ks); buf[4 + r4] = S5_FRAG(2, 4 * hh + r4, ks); } }
        else { const int ks = gi - 8;
#pragma unroll
            for (int rb = 0; rb < 8; ++rb) buf[rb] = S5_FRAG(0, rb, ks); }
    };
    s16x8 wf[3][8];
    if (PASS == 1) {
#pragma unroll
        for (int ks = 0; ks < 3; ++ks)
#pragma unroll
            for (int rb = 0; rb < 8; ++rb) wf[ks][rb] = S5_FRAG(0, rb, ks);
    }
    u32x4 cu[4];
#pragma unroll
    for (int ks = 0; ks < 4; ++ks) cu[ks] = ldu(t0 + 2 * ks + (q >> 1));
#pragma unroll 1
    for (int blk = 0; blk < nblk; ++blk) {
        const int tb = t0 + 8 * blk;
        u32x4 nu[4];
#pragma unroll
        for (int ks = 0; ks < 4; ++ks) nu[ks] = ldu(tb + 8 + 2 * ks + (q >> 1));
        s16x8 ubf[4], xb[4];
#pragma unroll
        for (int ks = 0; ks < 4; ++ks) { union { u32x4 u; s16x8 s; } cv; cv.u = cu[ks]; ubf[ks] = cv.s; xb[ks] = cv.s; }
        if (PASS == 2) { union { u32x4 u; s16x8 s; } cv;
            cv.u = gm::pack8(xr[0], xr[1]); xb[0] = cv.s; cv.u = gm::pack8(xr[2], xr[3]); xb[1] = cv.s;
            cv.u = gm::pack8(xi[0], xi[1]); xb[2] = cv.s; cv.u = gm::pack8(xi[2], xi[3]); xb[3] = cv.s; }
        f32x4 acc[8];
#pragma unroll
        for (int k = 0; k < 8; ++k) acc[k] = (f32x4){0.f, 0.f, 0.f, 0.f};
        if (PASS == 2) loadg(G0, fa[G0 & 1]); else loadg(11, fa[1]);
#pragma unroll
        for (int gi = G0; gi < 12; ++gi) {
            if (PASS == 2 && gi + 1 < 12) loadg(gi + 1, fa[(gi + 1) & 1]);
            s16x8 (&f)[8] = (PASS == 1 && gi < 11) ? wf[gi >= 8 && gi < 11 ? gi - 8 : 0] : fa[gi & 1];
            if (gi < 8) { const int hh = gi >> 2, ks = gi & 3;
#pragma unroll
                for (int r4 = 0; r4 < 4; ++r4) { acc[r4] = __builtin_amdgcn_mfma_f32_16x16x32_bf16(f[r4], xb[ks], acc[r4], 0, 0, 0); acc[4 + r4] = __builtin_amdgcn_mfma_f32_16x16x32_bf16(f[4 + r4], ubf[ks], acc[4 + r4], 0, 0, 0); }
                if (ks == 3) {
#pragma unroll
                    for (int r4 = 0; r4 < 4; ++r4) { const f32x4 y = acc[r4] + acc[4 + r4]; f32x4 z;
#pragma unroll
                        for (int i = 0; i < 4; ++i) { const float v = y[i]; z[i] = v * sigmoid_f(1.5957691216f * (v + 0.044715f * v * v * v)); }
                        if (c < NCH) { const f32x4 zc = __builtin_elementwise_min(z * 16.f, (f32x4){440.f, 440.f, 440.f, 440.f});
                            *(unsigned*)(z8b + (size_t)rowidx(n, tb + 4 * hh + r4) * 16) = cvt_pk4_fp8(zc[0], zc[1], zc[2], zc[3]); }
                        else *(u32x2*)(zb + (size_t)(tb + 4 * hh + r4) * 16) = (u32x2){cvt_pk_bf16(z[0], z[1]), cvt_pk_bf16(z[2], z[3])};
                        acc[r4] = (f32x4){0.f, 0.f, 0.f, 0.f}; acc[4 + r4] = (f32x4){0.f, 0.f, 0.f, 0.f}; }
                }
            } else { const int ks = gi - 8;
#pragma unroll
                for (int rb = 0; rb < 8; ++rb) acc[rb] = __builtin_amdgcn_mfma_f32_16x16x32_bf16(f[rb], ubf[ks], acc[rb], 0, 0, 0);
            }
            __builtin_amdgcn_sched_barrier(0);
        }
#pragma unroll
        for (int r = 0; r < 4; ++r) { const f32x4 ar = *(const LAS f32x4*)(a8 + 16 * r + 4 * q), ai = *(const LAS f32x4*)(a8 + NST + 16 * r + 4 * q);
            const f32x4 nr = ar * xr[r] - ai * xi[r] + acc[r], ni = ar * xi[r] + ai * xr[r] + acc[4 + r]; xr[r] = nr; xi[r] = ni; }
#pragma unroll
        for (int ks = 0; ks < 4; ++ks) cu[ks] = nu[ks];
    }
#undef S5_FRAG
    if (PASS == 1) {
        float* sp = SL + ((size_t)(g * (NCH + 1) + c) * 32) * 64 + lane;
#pragma unroll
        for (int r = 0; r < 4; ++r)
#pragma unroll
            for (int i = 0; i < 4; ++i) { sp[(r * 4 + i) * 64] = xr[r][i]; sp[(16 + r * 4 + i) * 64] = xi[r][i]; }
    }
}
template <int PASS>
__device__ __forceinline__ void s5_scan(const Params& P, int j, LAS unsigned char* lds, int wave, int lane) {
    unsigned char* ws = P.ws; const int tid = wave * 64 + lane, q = lane >> 4;
    for (int bj = blockIdx.x; bj < 2 * NG; bj += gridDim.x) {
        const int g = bj >> 1, half = bj & 1;
        int c = half * 8 + wave;
        f32x4 xr0[4], xi0[4];
#pragma unroll
        for (int r = 0; r < 4; ++r) { xr0[r] = (f32x4){0.f, 0.f, 0.f, 0.f}; xi0[r] = xr0[r]; }
        __syncthreads();
        if (PASS == 2) {
            { const unsigned char* src = ws + WS_SLOC + (size_t)g * (NCH + 1) * 8192;
#pragma unroll
              for (int o = 0; o < (NCH + 1) * 8192; o += NTHR * 16) __builtin_amdgcn_global_load_lds((const unsigned*)(src + o + tid * 16), (LAS unsigned*)(lds + o + wave * 1024), 16, 0, 0);
              VM_WAIT(); }
            __syncthreads();
            const float* TL = (const float*)(ws + WS_S5L) + (size_t)(j * NG + g) * 2 * NST;
            f32x4 lr[4], li[4];
#pragma unroll
            for (int r = 0; r < 4; ++r) { lr[r] = *(const f32x4*)(TL + 16 * r + 4 * q); li[r] = *(const f32x4*)(TL + NST + 16 * r + 4 * q); }
            { const LAS float* sp = (const LAS float*)(lds + NCH * 8192) + lane;
#pragma unroll
              for (int r = 0; r < 4; ++r)
#pragma unroll
                  for (int i = 0; i < 4; ++i) { xr0[r][i] = sp[(r * 4 + i) * 64]; xi0[r][i] = sp[(16 + r * 4 + i) * 64]; } }
            for (int cc = 0; cc < c; ++cc) {
                const LAS float* sp = (const LAS float*)(lds + cc * 8192) + lane;
#pragma unroll
                for (int r = 0; r < 4; ++r) { f32x4 sr, si;
#pragma unroll
                    for (int i = 0; i < 4; ++i) { sr[i] = sp[(r * 4 + i) * 64]; si[i] = sp[(16 + r * 4 + i) * 64]; }
                    const f32x4 nr = lr[r] * xr0[r] - li[r] * xi0[r] + sr, ni = lr[r] * xi0[r] + li[r] * xr0[r] + si; xr0[r] = nr; xi0[r] = ni; }
            }
            __syncthreads();
        }
        { const unsigned char* src = ws + WS_S5T + (size_t)(j * NG + g) * 3 * 32768; const int nbytes = PASS == 1 ? 32768 : 3 * 32768;
#pragma unroll
          for (int o = 0; o < nbytes; o += NTHR * 16) __builtin_amdgcn_global_load_lds((const unsigned*)(src + o + tid * 16), (LAS unsigned*)(lds + o + wave * 1024), 16, 0, 0);
          { const int t2 = wave * 64 + opaque_lane();
            if (t2 < 128) ((LAS float*)(lds + 3 * 32768))[t2] = ((const float*)(ws + WS_S5A))[(size_t)(j * NG + g) * 2 * NST + t2]; }
          VM_WAIT(); }
        __syncthreads();
        if (PASS == 1) { if (c == NCH - 1) c = NCH; s5_chunk<1>(ws, j, g, c, lds, lane, xr0, xi0); }
        else { const int nrun = (c == 0) ? 2 : 1;
#pragma unroll 1
            for (int rr = 0; rr < nrun; ++rr) {
                if (rr) {
#pragma unroll
                    for (int r = 0; r < 4; ++r) { xr0[r] = (f32x4){0.f, 0.f, 0.f, 0.f}; xi0[r] = xr0[r]; } }
                s5_chunk<2>(ws, j, g, rr ? NCH : c, lds, lane, xr0, xi0); } }
    }
}

template <int W>
__device__ __forceinline__ void pool_item8(const bf16_t* U, bf16_t* H, unsigned char* H8, const float* scale, int b, int tt0, int c8) {
    u32x4 r[W + 7], hv[8];
#pragma unroll
    for (int k = 0; k < W + 7; ++k) { const int tt = tt0 - (W - 1) + k; r[k] = (u32x4){0u, 0u, 0u, 0u}; if (tt >= 0) r[k] = *(const u32x4*)(U + (size_t)rowidx(b, tt) * D + c8 * 8); }
#pragma unroll
    for (int o = 0; o < 8; ++o) hv[o] = *(const u32x4*)(H + (size_t)rowidx(b, tt0 + o) * D + c8 * 8);
    const f32x4 sc0 = *(const f32x4*)(scale + c8 * 8), sc1 = *(const f32x4*)(scale + c8 * 8 + 4);
    f32x4 s0 = (f32x4){0.f, 0.f, 0.f, 0.f}, s1 = s0;
#pragma unroll
    for (int k = 0; k < W - 1; ++k) { f32x4 a, c; gm::unpack8(r[k], a, c); s0 += a; s1 += c; }
#pragma unroll
    for (int o = 0; o < 8; ++o) {
        f32x4 a, c; gm::unpack8(r[o + W - 1], a, c); s0 += a; s1 += c;
        if (o > 0) { f32x4 pa, pc; gm::unpack8(r[o - 1], pa, pc); s0 -= pa; s1 -= pc; }
        const int tt = tt0 + o; const float inv = 1.0f / (float)((tt + 1) < W ? (tt + 1) : W);
        f32x4 h0, h1; gm::unpack8(hv[o], h0, h1);
        h0 += (s0 * inv - a) * sc0; h1 += (s1 * inv - c) * sc1;
        const size_t off = (size_t)rowidx(b, tt) * D + c8 * 8;
        *(u32x4*)(H + off) = gm::pack8(h0, h1);
        *(u32x2*)(H8 + off) = (u32x2){cvt_pk4_fp8(h0[0], h0[1], h0[2], h0[3]), cvt_pk4_fp8(h1[0], h1[1], h1[2], h1[3])};
    }
}
__device__ __forceinline__ void pool_phase(const Params& P, int j, int wave, int lane) {
    const bf16_t* U = (const bf16_t*)(P.ws + WS_U); bf16_t* H = (bf16_t*)(P.ws + WS_H); unsigned char* H8 = P.ws + WS_H8; const float* scale = P.in[I_PSCALE] + j * D;
    const int NGT = gridDim.x * NTHR;
    constexpr int NIT = (NREAL / 8 + NMETA / 8) * 256;
    for (int it = blockIdx.x * NTHR + wave * 64 + lane; it < NIT; it += NGT) {
        const int c8 = it & 255, pb = it >> 8, g = c8 >> 6;
        const int b = pb < NREAL / 8 ? (pb >> 8) : 0, tt0 = pb < NREAL / 8 ? ((pb & 255) * 8 + NMETA) : (pb - NREAL / 8) * 8;
        if (g == 0) pool_item8<2>(U, H, H8, scale, b, tt0, c8); else if (g == 1) pool_item8<4>(U, H, H8, scale, b, tt0, c8); else if (g == 2) pool_item8<8>(U, H, H8, scale, b, tt0, c8); else pool_item8<16>(U, H, H8, scale, b, tt0, c8);
    }
}

__device__ __forceinline__ void router_phase(const Params& P, int i, LAS unsigned char* lds, int wave, int lane) {
    unsigned char* ws = P.ws;
    const bf16_t* H = (const bf16_t*)(ws + WS_H); const u32x4* RT = (const u32x4*)(ws + WS_RT) + (size_t)i * 64 * 3 * 64 + lane;
    unsigned* cnt = (unsigned*)ws + CW_CNT + i * 64; u32x4* SI0 = (u32x4*)(ws + WS_SINF); u32x4* SI1 = (u32x4*)(ws + WS_SINF + SI_RANK);
    LAS float* lg = (LAS float*)(lds + LDS_STAGE) + wave * (32 * 49);
    LAS float* lb = (LAS float*)(lds + LDS_STAGE) + 8 * (32 * 49);
    __syncthreads();
    if (wave == 0 && lane < 36) lb[lane] = lane < 4 ? P.in[I_BC][i * 4 + lane] : P.in[I_BF][i * 32 + lane - 4];
    __syncthreads();
    const int NGW = gridDim.x * NWAVES, tok = lane & 15, q = lane >> 4;
    LAS float* px = (LAS float*)(lds + LDS_STAGE) + 8 * (32 * 49) + 64;
    LAS unsigned* lcnt = (LAS unsigned*)(lds + LDS_STAGE) + 20480;
    LAS unsigned* lbase = lcnt + 256;
    const int wq = wave & 3, kh = wave >> 2, njobs = (NROWS + 31) / 32;
    for (int base = 0; base + (int)blockIdx.x < njobs; base += 4 * (int)gridDim.x) {
        const int jb = base + wq * (int)gridDim.x + (int)blockIdx.x; const bool live = jb < njobs; const int job = live ? jb : 0;
        if (wave * 64 + lane < 64 + NCLS) lcnt[wave * 64 + lane] = 0u;
        const int row0 = job * 32;
        const bf16_t* hp = H + (size_t)(row0 + tok) * D + 8 * q;
        const size_t hb_off = (row0 + 16 < NROWS) ? (size_t)16 * D : 0;
        f32x4 a0 = (f32x4){0.f, 0.f, 0.f, 0.f}, a1 = a0, a2 = a0, b0 = a0, b1 = a0, b2 = a0; float ssa = 0.f, ssb = 0.f;
        if (live) {
#pragma unroll 8
        for (int ks = 32 * kh; ks < 32 * kh + 32; ++ks) {
            const u32x4 ha = *(const u32x4*)(hp + 32 * ks), hb = *(const u32x4*)(hp + hb_off + 32 * ks);
            const u32x4 w0 = RT[(ks * 3 + 0) * 64], w1 = RT[(ks * 3 + 1) * 64], w2 = RT[(ks * 3 + 2) * 64];
            { const float f0 = bf_lo(ha.x), f1 = bf_hi(ha.x), f2 = bf_lo(ha.y), f3 = bf_hi(ha.y), f4 = bf_lo(ha.z), f5 = bf_hi(ha.z), f6 = bf_lo(ha.w), f7 = bf_hi(ha.w);
              ssa += (f0 * f0 + f1 * f1) + (f2 * f2 + f3 * f3) + (f4 * f4 + f5 * f5) + (f6 * f6 + f7 * f7); }
            { const float f0 = bf_lo(hb.x), f1 = bf_hi(hb.x), f2 = bf_lo(hb.y), f3 = bf_hi(hb.y), f4 = bf_lo(hb.z), f5 = bf_hi(hb.z), f6 = bf_lo(hb.w), f7 = bf_hi(hb.w);
              ssb += (f0 * f0 + f1 * f1) + (f2 * f2 + f3 * f3) + (f4 * f4 + f5 * f5) + (f6 * f6 + f7 * f7); }
            union { u32x4 u; s16x8 s; } ca, cb, c0, c1, c2; ca.u = ha; cb.u = hb; c0.u = w0; c1.u = w1; c2.u = w2;
            a0 = __builtin_amdgcn_mfma_f32_16x16x32_bf16(c0.s, ca.s, a0, 0, 0, 0);
            a1 = __builtin_amdgcn_mfma_f32_16x16x32_bf16(c1.s, ca.s, a1, 0, 0, 0);
            a2 = __builtin_amdgcn_mfma_f32_16x16x32_bf16(c2.s, ca.s, a2, 0, 0, 0);
            b0 = __builtin_amdgcn_mfma_f32_16x16x32_bf16(c0.s, cb.s, b0, 0, 0, 0);
            b1 = __builtin_amdgcn_mfma_f32_16x16x32_bf16(c1.s, cb.s, b1, 0, 0, 0);
            b2 = __builtin_amdgcn_mfma_f32_16x16x32_bf16(c2.s, cb.s, b2, 0, 0, 0);
        } }
        { LAS float* pp = px + wq * (26 * 64) + lane;
          if (kh == 1) {
#pragma unroll
              for (int r = 0; r < 4; ++r) { pp[(0 + r) * 64] = a0[r]; pp[(4 + r) * 64] = a1[r]; pp[(8 + r) * 64] = a2[r]; pp[(12 + r) * 64] = b0[r]; pp[(16 + r) * 64] = b1[r]; pp[(20 + r) * 64] = b2[r]; }
              pp[24 * 64] = ssa; pp[25 * 64] = ssb; }
          __syncthreads();
          if (kh == 0) {
#pragma unroll
              for (int r = 0; r < 4; ++r) { a0[r] += pp[(0 + r) * 64]; a1[r] += pp[(4 + r) * 64]; a2[r] += pp[(8 + r) * 64]; b0[r] += pp[(12 + r) * 64]; b1[r] += pp[(16 + r) * 64]; b2[r] += pp[(20 + r) * 64]; }
              ssa += pp[24 * 64]; ssb += pp[25 * 64]; }
          __syncthreads(); }
        const bool act = (kh == 0) && live;
        bool tokv = false; int ea = 0, eb = 0, cls = 0, trow = 0, swp = 0; float wa = 0.f, wb = 0.f, rstd = 0.f; unsigned la = 0u, lbi = 0u, lc = 0u;
        if (act) {
            ssa += __shfl_xor(ssa, 16); ssa += __shfl_xor(ssa, 32); ssb += __shfl_xor(ssb, 16); ssb += __shfl_xor(ssb, 32);
            const float rsa = rsqrtf(ssa * (1.0f / D) + RMS_EPS), rsb = rsqrtf(ssb * (1.0f / D) + RMS_EPS);
#pragma unroll
            for (int r = 0; r < 4; ++r) {
                lg[tok * 49 + 4 * q + r] = a0[r] * rsa; lg[tok * 49 + 16 + 4 * q + r] = a1[r] * rsa; lg[tok * 49 + 32 + 4 * q + r] = a2[r] * rsa;
                lg[(16 + tok) * 49 + 4 * q + r] = b0[r] * rsb; lg[(16 + tok) * 49 + 16 + 4 * q + r] = b1[r] * rsb; lg[(16 + tok) * 49 + 32 + 4 * q + r] = b2[r] * rsb; }
            const float rs_b = __shfl(rsb, lane & 15);
            LDS_WAIT();
            if (lane < 32 && row0 + lane < NROWS) {
                rstd = lane < 16 ? rsa : rs_b;
                const LAS float* l = lg + lane * 49;
                float cm = l[0] + lb[0]; int grp = 0;
#pragma unroll
                for (int k = 1; k < 4; ++k) { const float v = l[k] + lb[k]; if (v > cm) { cm = v; grp = k; } }
                float cs = 0.f;
#pragma unroll
                for (int k = 0; k < 4; ++k) cs += __expf(l[k] + lb[k] - cm);
                const float pg = 1.0f / cs;
                float f1 = -3.0e38f, f2 = -3.0e38f; int e1 = 0, e2 = 0;
#pragma unroll
                for (int k = 0; k < 8; ++k) { const float v = l[4 + 8 * grp + k] + lb[4 + 8 * grp + k];
                    if (v > f1) { f2 = f1; e2 = e1; f1 = v; e1 = k; } else if (v > f2) { f2 = v; e2 = k; } }
                const float ex = __expf(f2 - f1); wa = pg / (1.0f + ex); wb = pg * ex / (1.0f + ex);
                ea = 8 * grp + e1; eb = 8 * grp + e2; trow = row0 + lane; swp = e1 > e2 ? 1 : 0;
                const int lo = e1 < e2 ? e1 : e2, hi2 = e1 < e2 ? e2 : e1; cls = 28 * grp + (lo * (15 - lo)) / 2 + (hi2 - lo - 1);
                la = __hip_atomic_fetch_add(lcnt + ea, 1u, __ATOMIC_RELAXED, __HIP_MEMORY_SCOPE_WORKGROUP);
                lbi = __hip_atomic_fetch_add(lcnt + 32 + eb, 1u, __ATOMIC_RELAXED, __HIP_MEMORY_SCOPE_WORKGROUP);
                lc = __hip_atomic_fetch_add(lcnt + 64 + cls, 1u, __ATOMIC_RELAXED, __HIP_MEMORY_SCOPE_WORKGROUP);
                tokv = true;
            }
        }
        __syncthreads();
        { const int t = wave * 64 + lane;
          if (t < 64 + NCLS) { const unsigned n = lcnt[t];
              if (n) lbase[t] = __hip_atomic_fetch_add(t < 64 ? cnt + t : cnt + (CW_CC - CW_CNT) + (128 - 64) * i + (t - 64), n, __ATOMIC_RELAXED, __HIP_MEMORY_SCOPE_AGENT); } }
        __syncthreads();
        if (tokv) {
            const unsigned pa = lbase[ea] + la, pb = lbase[32 + eb] + lbi, pc = lbase[64 + cls] + lc;
            ((float*)(ws + WS_RQ))[trow] = rstd;
            SI0[(size_t)ea * CAP + pa] = (u32x4){(unsigned)trow, __float_as_uint(wa), __float_as_uint(rstd), 0u};
            SI1[(size_t)eb * CAP + pb] = (u32x4){(unsigned)trow, __float_as_uint(wb), __float_as_uint(rstd), 0u};
            ((u32x4*)(ws + WS_SC))[(size_t)cls * CAP + pc] = (u32x4){(unsigned)trow | (swp ? 0x80000000u : 0u), 0u, __float_as_uint(rstd), 0u};
        }
    }
}

__device__ __forceinline__ void moe_tables(const Params& P, int i, LAS int* misc, int wave, int lane) {
    __syncthreads();
    if (wave == 0) {
        const unsigned* cnt = (const unsigned*)P.ws + CW_CNT + i * 64;
        const int n0 = lane < 32 ? (int)__hip_atomic_load(cnt + (lane & 31), __ATOMIC_RELAXED, __HIP_MEMORY_SCOPE_AGENT) : 0;
        const int n1 = lane < 32 ? (int)__hip_atomic_load(cnt + 32 + (lane & 31), __ATOMIC_RELAXED, __HIP_MEMORY_SCOPE_AGENT) : 0;
        int tg = (n0 + n1 + 255) >> 8, ta = (n0 + 255) >> 8, tb = (n1 + 255) >> 8, sl = n0 + n1;
#pragma unroll
        for (int o = 1; o < 32; o <<= 1) { const int a1 = __shfl_up(tg, o), a2 = __shfl_up(ta, o), a3 = __shfl_up(tb, o), a4 = __shfl_up(sl, o); if (lane >= o) { tg += a1; ta += a2; tb += a3; sl += a4; } }
        if (lane < 32) { misc[16 + lane + 1] = tg; misc[64 + lane + 1] = sl; misc[112 + lane + 1] = ta; misc[160 + lane + 1] = tb; misc[208 + lane] = n0; }
        if (lane == 0) { misc[16] = 0; misc[64] = 0; misc[112] = 0; misc[160] = 0; }
    }
    if (wave == 1) {
        const unsigned* cc = (const unsigned*)P.ws + CW_CC + i * 128;
        const int na = lane < 56 ? (int)__hip_atomic_load(cc + 2 * lane, __ATOMIC_RELAXED, __HIP_MEMORY_SCOPE_AGENT) : 0;
        const int nb = lane < 56 ? (int)__hip_atomic_load(cc + 2 * lane + 1, __ATOMIC_RELAXED, __HIP_MEMORY_SCOPE_AGENT) : 0;
        const int fa = (na >> 8) + ((na & 255) > 128 ? 1 : 0), fb = (nb >> 8) + ((nb & 255) > 128 ? 1 : 0);
        const int ha = ((na & 255) >= 1 && (na & 255) <= 128) ? 1 : 0, hb = ((nb & 255) >= 1 && (nb & 255) <= 128) ? 1 : 0;
        int sf = fa + fb, sh = ha + hb;
#pragma unroll
        for (int o = 1; o < 64; o <<= 1) { const int a1 = __shfl_up(sf, o), a2 = __shfl_up(sh, o); if (lane >= o) { sf += a1; sh += a2; } }
        if (lane < 56) { misc[256 + 2 * lane + 1] = sf - fb; misc[256 + 2 * lane + 2] = sf; misc[384 + 2 * lane + 1] = sh - hb; misc[384 + 2 * lane + 2] = sh; misc[512 + 2 * lane] = na; misc[512 + 2 * lane + 1] = nb; }
        if (lane == 0) { misc[256] = 0; misc[384] = 0; }
        if (lane < 28) { int lo = 0, r = lane;
#pragma unroll
            for (int k = 0; k < 7; ++k) if (r >= 7 - lo) { r -= 7 - lo; ++lo; }
            misc[640 + lane] = lo | ((lo + 1 + r) << 4); }
    }
    __syncthreads();
}

__device__ __forceinline__ void finalize_phase(const Params& P, int i, int wave, int lane) {
    unsigned char* ws = P.ws; const float* SSP = (const float*)(ws + WS_SSP);
    if (i < 3) {
        float* RS = (float*)(ws + WS_RSTD); const int NGT = gridDim.x * NTHR;
        for (int row = blockIdx.x * NTHR + wave * 64 + lane; row < NROWS; row += NGT) {
            const f32x4* p = (const f32x4*)(SSP + (size_t)row * 32); f32x4 a = p[0];
#pragma unroll
            for (int k = 1; k < 8; ++k) a += p[k];
            RS[row] = rsqrtf(((a[0] + a[1]) + (a[2] + a[3])) * (1.0f / D) + RMS_EPS);
        }
    } else {
        const bf16_t* H = (const bf16_t*)(ws + WS_H); const float* gf = P.in[I_NFIN]; const int NGW = gridDim.x * NWAVES;
        for (int row0 = blockIdx.x * NWAVES + wave; row0 < NREAL; row0 += 4 * NGW) {
            float sp[4]; u32x4 hv[4][4];
#pragma unroll
            for (int r = 0; r < 4; ++r) { const int row = row0 + r * NGW; sp[r] = (lane < 32 && row < NREAL) ? SSP[(size_t)row * 32 + lane] : 0.f;
#pragma unroll
                for (int jj = 0; jj < 4; ++jj) { hv[r][jj] = (u32x4){0u, 0u, 0u, 0u}; if (row < NREAL) hv[r][jj] = *(const u32x4*)(H + (size_t)row * D + lane * 8 + 512 * jj); } }
#pragma unroll
            for (int r = 0; r < 4; ++r) { const int row = row0 + r * NGW; if (row >= NREAL) break;
                const float rstd = rsqrtf(wave_sum(sp[r]) * (1.0f / D) + RMS_EPS);
#pragma unroll
                for (int jj = 0; jj < 4; ++jj) { const int c = lane * 8 + 512 * jj; f32x4 h0, h1; gm::unpack8(hv[r][jj], h0, h1);
                    *(f32x4*)(P.out + (size_t)row * D + c) = h0 * rstd * *(const f32x4*)(gf + c);
                    *(f32x4*)(P.out + (size_t)row * D + c + 4) = h1 * rstd * *(const f32x4*)(gf + c + 4); } }
        }
    }
}

constexpr int NPHASE = 39;
__global__ void __launch_bounds__(NTHR, 2) trunk_fwd(Params P) {
    extern __shared__ __attribute__((aligned(16))) unsigned char lds_raw[];
    LAS unsigned char* lds = (LAS unsigned char*)lds_raw;
    LAS int* misc = (LAS int*)(lds + LDS_MISC);
    const int wave0 = __builtin_amdgcn_readfirstlane(threadIdx.x >> 6);
    if (threadIdx.x < 128) misc[threadIdx.x] = 0;
    __syncthreads();
    XcdBarrier bar; bar.bar = (unsigned*)P.ws; bar.x = 0; bar.st = nullptr;
    if (ONE_LAUNCH) bar = xcd_barrier_post((unsigned*)P.ws, (volatile LAS unsigned*)misc);
    const int lo = P.ph_lo, hi = P.ph_hi;
#define IN(k) (lo <= (k) && (k) < hi)
#define SEAM(k) do { if (ONE_LAUNCH) { if (IN(k) && IN((k) + 1)) xcd_barrier(bar); } } while (0)
    LAS unsigned char* stage = lds + LDS_STAGE; LAS unsigned char* linfo = lds + LDS_INFO;

    if (EN_P0 && IN(0)) { for (int rep = 0; rep < REP_P0; ++rep) { phase0(P, lds, wave0, opaque_lane()); VM_WAIT(); __syncthreads(); } }
    SEAM(0);
    if (IN(1)) {
        const int c = blockIdx.x, jl = c >> 6;
        if (c < 128) {
            gm::DenseOrder S; S.nM = 8; S.nN = 8; S.nwg = 64; S.G = 1 << 20; S.c = c & 63;
            S.A = (const char*)(P.ws + WS_GRP) + (size_t)jl * D * 512 * 2; S.aTile = (size_t)256 * 512 * 2; S.kofs_per_pn2 = 0;
            S.Bt = (const char*)(P.ws + WS_WINO) + (size_t)jl * D * D * 2; S.bTile = (size_t)256 * D * 2; S.kofsB_per_pm2 = 512 * 2;
            gm::EpiDn E{(bf16_t*)(P.ws + WS_WIN) + (size_t)(2 * jl + 1) * D * D, (unsigned*)P.ws + CW_AM + (2 * jl + 1) * D};
            gm::gemm_phase<gm::EpiDn, gm::DenseOrder, false, false>(stage, linfo, 512, 512, S, E, wave0, D);
        } else {
            const int lane = opaque_lane(); LAS float* scr = (LAS float*)(lds + LDS_STAGE) + wave0 * (64 * 65);
            for (int it = (c - 128) * NWAVES + wave0; it < 2 * 1024; it += ((int)gridDim.x - 128) * NWAVES) {
                const int i = (it >> 10) * 2, rr = it & 1023, kb = rr >> 5, nb = rr & 31;
                ConvDesc d; d.w = P.in[I_S5WIN] + (size_t)(i >> 1) * D * D + (size_t)(kb * 64) * D + nb * 64; d.gain = P.in[I_NMIX] + i * D + kb * 64;
                d.dst = P.ws + WS_WI8 + (size_t)i * D * D + kb * 64; d.ldw = D; d.Kd = D; d.kind = 0; d.off = 0; d.n0 = nb * 64; d.esz = 1; d.wscale = 1.f;
                f32x4 v[16]; conv_load(d, v, lane); conv_store_i8(d, v, scr, lane, (const unsigned*)P.ws + CW_AM + i * D);
            }
        }
    }
    SEAM(1);

#pragma unroll 1
    for (int i = 0; i < 4; ++i) {
        const int pb = 3 + 9 * i, j = i >> 1; const bool s5 = (i & 1) == 0;
        const int lane = opaque_lane();
        unsigned char* ws = P.ws; int G = gridDim.x, c = blockIdx.x, wave = wave0;
        asm volatile("" : "+s"(ws), "+s"(G), "+s"(c), "+s"(wave));
        if (EN_WIN && IN(pb + 0)) {
            gm::DenseOrder S; S.nM = NREAL / 256; S.nN = 8; S.nwg = S.nM * S.nN; S.G = G; S.c = c; S.A = (const char*)(ws + WS_H); S.Bt = (const char*)(ws + WS_WIN) + (size_t)i * D * D * 2;
            S.aTile = (size_t)256 * D * 2; S.bTile = (size_t)256 * D * 2; S.kofs_per_pn2 = 0;
            LAS float* rtab = (LAS float*)linfo; LAS float* ctab = rtab + 1024;
            { const float* RS0 = (const float*)(ws + WS_RSTD); const float* SSP = (const float*)(ws + WS_SSP); const float* RQ = (const float*)(ws + WS_RQ); const int t256 = (wave & 3) * 64 + lane, hi = wave >> 2;
              const unsigned* AM = (const unsigned*)ws + CW_AM + i * D;
              __syncthreads();
#pragma unroll
              for (int k = 0; k < 4; ++k) { const int n = (wave * 64 + lane) + 512 * k; ctab[n] = fmaxf(__uint_as_float(AM[n]), 1e-30f) * (1.0f / 127.0f); }
#pragma unroll 1
              for (int k2 = 0; k2 < 4; k2 += 2) { gm::Unit uk; if (!S.next(k2 + hi, uk)) continue;
                  int row = uk.orow + t256; asm volatile("" : "+v"(row)); float rs;
                  if (i == 0) rs = RS0[row];
                  else { const f32x4* pp = (const f32x4*)(SSP + (size_t)row * 32); f32x4 a = pp[0];
#pragma unroll
                      for (int k = 1; k < 8; ++k) a += pp[k];
                      rs = rsqrtf(((a[0] + a[1]) + (a[2] + a[3])) * (1.0f / D) + RMS_EPS); }
                  rtab[(k2 + hi) * 256 + t256] = rs * (QCLIP / 127.0f) / RQ[row]; }
              __syncthreads(); }
            S.A = (const char*)(ws + WS_HI8); S.Bt = (const char*)(ws + WS_WI8) + (size_t)i * D * D; S.aTile = (size_t)256 * D; S.bTile = (size_t)256 * D;
            gm::EpiU E{(bf16_t*)(ws + WS_U), rtab, ctab, s5 ? 1 : 0};
            gm::gemm_phase<gm::EpiU, gm::DenseOrder, false, false, false, 2>(stage, linfo, D / 2, D / 2, S, E, wave);
            if (c < 128) meta_gemm<0>(stage, (const bf16_t*)(ws + WS_WIN) + (size_t)i * D * D, D, 16 * c, 0, (const bf16_t*)(ws + WS_H) + (size_t)NREAL * D, (bf16_t*)(ws + WS_U), (const float*)(ws + WS_RSTD), c, wave, lane, s5 ? 1 : 0, nullptr, i == 0 ? nullptr : (const float*)(ws + WS_SSP));
        }
        SEAM(pb + 0);
        if (s5) {
            if (i == 0 && IN(pb + 1)) {
                for (int id = c * NTHR + wave * 64 + lane; id < 2 * D * (D / 8); id += G * NTHR) {
                    const int k8 = id & 255, n = (id >> 8) & 2047, il = 2 * (id >> 19) + 1;
                    const float qs = 127.0f / fmaxf(__uint_as_float(((const unsigned*)ws)[CW_AM + il * D + n]), 1e-30f);
                    f32x4 a, b; gm::unpack8(*(const u32x4*)((const bf16_t*)(ws + WS_WIN) + ((size_t)il * D + n) * D + k8 * 8), a, b);
                    *(u32x2*)(ws + WS_WI8 + ((size_t)il * D + n) * D + k8 * 8) = pack8_i8(a * qs, b * qs);
                }
            }
            if (EN_S51 && IN(pb + 1)) for (int rep = 0; rep < REP_S5; ++rep) s5_scan<1>(P, j, stage, wave, lane);
            SEAM(pb + 1);
            if (EN_S52 && IN(pb + 2)) for (int rep = 0; rep < REP_S5; ++rep) s5_scan<2>(P, j, stage, wave, lane);
            SEAM(pb + 2);
            if (EN_GLU && IN(pb + 3)) {
                gm::DenseOrder S; S.nM = NREAL / 256; S.nN = 16; S.nwg = S.nM * S.nN; S.G = G; S.c = c; S.A = (const char*)(ws + WS_Z8); S.Bt = (const char*)(ws + WS_GLU8) + (size_t)j * 4096 * D;
                S.aTile = (size_t)256 * 16; S.bTile = (size_t)256 * D; S.kofs_per_pn2 = 0;
                gm::EpiGlu E{(bf16_t*)(ws + WS_H), ws + WS_H8, 1.0f / 512.0f};
                gm::gemm_phase<gm::EpiGlu, gm::DenseOrder, false, false, 2, 1>(stage, linfo, D / 2, D / 2, S, E, wave);
                if (c < 128) { const int wr0 = ((16 * c) >> 7) * 256 + ((16 * c) & 127);
                    meta_gemm<1>(stage, (const bf16_t*)(ws + WS_GLU) + (size_t)j * 4096 * D, D, wr0, wr0 + 128, (const bf16_t*)(ws + WS_ZM), (bf16_t*)(ws + WS_H), nullptr, c, wave, lane, 0, ws + WS_H8); }
            }
            SEAM(pb + 3);
        } else {
            if (EN_POOL && IN(pb + 1)) pool_phase(P, j, wave, lane);
            SEAM(pb + 1);
        }
        if (EN_RT && IN(pb + 4)) router_phase(P, i, lds, wave, lane);
        SEAM(pb + 4);
        if (EN_GU && IN(pb + 5)) {
            moe_tables(P, i, misc, wave, lane);
            gm::MoeOrder S; S.nN = 4; S.G = G; S.c = c; S.mode = 0; S.tp = misc + 16; S.sbe = misc + 64; S.c0 = misc + 208; S.A = (const char*)(ws + WS_H8); S.aRow = 0;
            S.Bt = (const char*)(ws + WS_GU) + (size_t)i * 32 * 1024 * D; S.bExp = (size_t)1024 * D; S.bTile = (size_t)256 * D; S.info = (const char*)(ws + WS_SINF);
            gm::EpiGU E{(bf16_t*)(ws + WS_HID)};
            gm::gemm_phase<gm::EpiGU, gm::MoeOrder, true, true, false, 1>(stage, linfo, D / 2, D / 2, S, E, wave);
        }
        SEAM(pb + 5);
        if (EN_DN && IN(pb + 7)) {
            if (!(IN(pb + 5))) moe_tables(P, i, misc, wave, lane);
            gm::PairOrder S; S.nN = 8; S.G = G; S.c = c; S.tp = misc + 256; S.tph = misc + 384; S.ncl = misc + 512; S.ptab = misc + 640; S.A = (const char*)(ws + WS_HID);
            S.Bt = (const char*)(ws + WS_DN) + (size_t)i * 32 * D * DE; S.bExp = (size_t)D * DE; S.bTile = (size_t)256 * DE; S.info = (const char*)(ws + WS_SC);
            gm::EpiAdd<true> E{(bf16_t*)(ws + WS_H), (float*)(ws + WS_SSP), 1.0f / 256.0f, i == 3 ? nullptr : ws + WS_HI8};
            gm::gemm_phase<gm::EpiAdd<true>, gm::PairOrder, true, true, false, 1, true>(stage, linfo, DE, DE, S, E, wave, DE / 2);
        }
        SEAM(pb + 7);
        if (EN_CMB && IN(pb + 8) && i == 3) finalize_phase(P, i, wave, lane);
    }
#ifdef DBG_LAST_PHASE
    if (IN(99)) {
        const bf16_t* H = (const bf16_t*)(P.ws + DBG_SRC); const int lane = opaque_lane();
        for (int row = blockIdx.x * NWAVES + wave0; row < NREAL; row += gridDim.x * NWAVES)
            for (int jj = 0; jj < 4; ++jj) { const int c = lane * 8 + 512 * jj; f32x4 a, b; gm::unpack8(*(const u32x4*)(H + (size_t)row * D + c), a, b);
                *(f32x4*)(P.out + (size_t)row * D + c) = a; *(f32x4*)(P.out + (size_t)row * D + c + 4) = b; }
    }
#endif
#undef IN
#undef SEAM
}

extern "C" void kernel_launch(void* const* d_in, const int* in_sizes, int n_in, void* d_out, int out_size, void* d_ws, size_t ws_size, hipStream_t stream) {
    static int grid = 0;
    if (grid == 0) {
        if (n_in != 25 || ws_size < WS_END) { fprintf(stderr, "kernel_launch: expected 25 inputs and >= %zu bytes of workspace (got %d, %zu)\n", (size_t)WS_END, n_in, ws_size); grid = -1; return; }
        int dev = 0, cus = 0, per_cu = 0;
        if (hipGetDevice(&dev) != hipSuccess || hipDeviceGetAttribute(&cus, hipDeviceAttributeMultiprocessorCount, dev) != hipSuccess) { grid = -1; return; }
        if (hipFuncSetAttribute((const void*)trunk_fwd, hipFuncAttributeMaxDynamicSharedMemorySize, LDS_BYTES) != hipSuccess) { fprintf(stderr, "kernel_launch: hipFuncSetAttribute failed\n"); grid = -1; return; }
        if (hipOccupancyMaxActiveBlocksPerMultiprocessor(&per_cu, (const void*)trunk_fwd, NTHR, LDS_BYTES) != hipSuccess || per_cu < 1) { fprintf(stderr, "kernel_launch: occupancy query says %d\n", per_cu); (void)hipGetLastError(); per_cu = 1; }
        grid = cus;
    }
    if (grid < 0) return;
    (void)hipMemsetAsync(d_ws, 0, CTL_BYTES, stream);
    Params p{};
    for (int i = 0; i < 25; ++i) p.in[i] = (const float*)d_in[i];
    p.out = (float*)d_out; p.ws = (unsigned char*)d_ws;
#if ONE_LAUNCH
    p.ph_lo = 0; p.ph_hi = NPHASE;
    hipLaunchKernelGGL(trunk_fwd, dim3(grid), dim3(NTHR), LDS_BYTES, stream, p);
#else
    for (int k = 0; k < NPHASE; ++k) {
        const int li = (k - 3) / 9, loc = (k - 3) % 9;
        if (k == 2 || (k > 2 && (((li & 1) == 1 && (loc == 2 || loc == 3)) || loc == 6))) continue;
#ifdef DBG_LAST_PHASE
        if (k > DBG_LAST_PHASE) break;
#endif
        p.ph_lo = k; p.ph_hi = k + 1;
        hipLaunchKernelGGL(trunk_fwd, dim3(grid), dim3(NTHR), LDS_BYTES, stream, p);
    }
#ifdef DBG_LAST_PHASE
    p.ph_lo = 99; p.ph_hi = 100;
    hipLaunchKernelGGL(trunk_fwd, dim3(grid), dim3(NTHR), LDS_BYTES, stream, p);
#endif
#endif
}
```

```cpp
#include <hip/hip_runtime.h>
#include <cstdio>
#include <cstdint>

#ifndef ONE_LAUNCH
#define ONE_LAUNCH 1
#endif

#define DBG_SRC WS_H
#ifndef REP_P0
#define REP_P0 1
#endif
#ifndef REP_WIN
#define REP_WIN 1
#endif
#ifndef REP_S5
#define REP_S5 1
#endif
#ifndef REP_POOL
#define REP_POOL 1
#endif
#ifndef REP_GU
#define REP_GU 1
#endif
#ifndef REP_DN
#define REP_DN 1
#endif

#ifndef EN_P0
#define EN_P0 1
#endif
#ifndef EN_WIN
#define EN_WIN 1
#endif
#ifndef EN_S51
#define EN_S51 1
#endif
#ifndef EN_S52
#define EN_S52 1
#endif
#ifndef EN_GLU
#define EN_GLU 1
#endif
#ifndef EN_POOL
#define EN_POOL 1
#endif
#ifndef EN_GRP
#define EN_GRP 1
#endif
#ifndef EN_RT
#define EN_RT 1
#endif
#ifndef EN_GU
#define EN_GU 1
#endif
#ifndef EN_DN
#define EN_DN 1
#endif
#ifndef EN_CMB
#define EN_CMB 1
#endif
#define LAS __attribute__((address_space(3)))
typedef unsigned short bf16_t;
typedef short s16x8 __attribute__((ext_vector_type(8)));
typedef short s16x4 __attribute__((ext_vector_type(4)));
typedef float f32x4 __attribute__((ext_vector_type(4)));
typedef float f32x2 __attribute__((ext_vector_type(2)));
typedef unsigned u32x4 __attribute__((ext_vector_type(4)));
typedef unsigned u32x2 __attribute__((ext_vector_type(2)));
typedef int i32x4 __attribute__((ext_vector_type(4)));

constexpr int D = 2048, NB = 16, SEQ = 2048, NMETA = 16, TT = SEQ + NMETA;
constexpr int NREAL = NB * SEQ;
constexpr int NROWS = NREAL + NMETA;
constexpr int NE = 32, DE = 512, CAP = NROWS, NSLOT = 2 * NROWS;
constexpr int NG = 128, NST = 64;
constexpr int NCH = 16, CL = SEQ / NCH;
constexpr float RMS_EPS = 1e-6f;
constexpr int NWAVES = 8, NTHR = 512;
constexpr size_t SI_RANK = 32ull * (NREAL + NMETA) * 16 + 65536;

__device__ __forceinline__ int rowidx(int b, int tt) { return tt < NMETA ? NREAL + tt : b * SEQ + (tt - NMETA); }

constexpr size_t CTL_BYTES = 131072;
constexpr int CW_CNT = 8192;
constexpr int CW_AM = 16384;
constexpr float QCLIP = 6.0f;
constexpr size_t WS_WIN  = CTL_BYTES;
constexpr size_t WS_GLU  = WS_WIN  + 4ull * 2048 * 2048 * 2;
constexpr size_t WS_GRP  = WS_GLU  + 2ull * 4096 * 2048 * 2;
constexpr size_t WS_GU   = WS_GRP  + 2ull * 2048 * 512 * 2;
constexpr size_t WS_DN   = WS_GU   + 4ull * 32 * 1024 * 2048 * 2;
constexpr size_t WS_RT   = WS_DN   + 4ull * 32 * 2048 * 512 * 2;
constexpr size_t WS_S5A  = WS_RT   + 4ull * 64 * 3 * 64 * 16;
constexpr size_t WS_S5L  = WS_S5A  + 2ull * 128 * 2 * 64 * 4;
constexpr size_t WS_S5B  = WS_S5L  + 2ull * 128 * 2 * 64 * 4;
constexpr size_t WS_S5C  = WS_S5B  + 2ull * 128 * 8 * 64 * 8;
constexpr size_t WS_S5T  = WS_S5C  + 2ull * 128 * 8 * 64 * 8;
constexpr size_t WS_H    = WS_S5T  + 2ull * 128 * 3 * 32768;
constexpr size_t WS_U    = WS_H    + (size_t)NROWS * 2048 * 2;
constexpr size_t WS_WINO = WS_U;
constexpr size_t WS_Z    = WS_U    + (size_t)NROWS * 2048 * 2;
constexpr size_t WS_Z8   = WS_Z;
constexpr size_t WS_ZM   = WS_Z + 100ull * 1024 * 1024;
constexpr size_t WS_RSTD = WS_Z    + (size_t)NROWS * 2048 * 2;
constexpr size_t WS_SLOC = WS_RSTD + (size_t)33024 * 4 + 256;
constexpr size_t WS_SINF = WS_SLOC + 128ull * (NCH + 1) * 32 * 64 * 4;
constexpr size_t WS_SSP  = WS_SINF + 2 * (32ull * CAP * 16 + 65536);
constexpr size_t WS_HID  = WS_SSP  + (size_t)33024 * 32 * 4;
constexpr size_t WS_Y    = WS_HID  + (size_t)(NSLOT + 256) * 512 * 2;
constexpr size_t WS_HI8  = WS_Y + 128ull * 1024 * 1024;
constexpr size_t WS_WI8  = WS_Y + 200ull * 1024 * 1024;
constexpr size_t WS_RQ   = WS_Y + 224ull * 1024 * 1024;
constexpr size_t WS_SC   = WS_Y + 65ull * 1024 * 1024;
constexpr int CW_CC = CW_CNT + 256;
constexpr int NCLS = 112;
constexpr size_t WS_GLU8 = WS_Y + 226ull * 1024 * 1024;
constexpr size_t WS_H8   = WS_Y;
constexpr size_t WS_END  = WS_Y    + (size_t)(NSLOT + 256) * 2048 * 2;

constexpr int LDS_STAGE = 0;
constexpr int LDS_INFO  = 131072;
constexpr int LDS_MISC  = 131072 + 12288;
constexpr int LDS_BYTES = 147456;

typedef __bf16 bf16x2_t __attribute__((ext_vector_type(2)));
__device__ __forceinline__ unsigned cvt_pk_bf16(float lo, float hi) { const f32x2 v = {lo, hi}; union { bf16x2_t b; unsigned u; } c; c.b = __builtin_convertvector(v, bf16x2_t); return c.u; }
typedef long i64x2 __attribute__((ext_vector_type(2)));
typedef int i32x8 __attribute__((ext_vector_type(8)));
__device__ __forceinline__ unsigned cvt_pk4_fp8(float a, float b, float c, float d) { int w = __builtin_amdgcn_cvt_pk_fp8_f32(a, b, 0, false); w = __builtin_amdgcn_cvt_pk_fp8_f32(c, d, w, true); return (unsigned)w; }
__device__ __forceinline__ unsigned q8(float x) { return (unsigned)(int)__builtin_rintf(__builtin_amdgcn_fmed3f(x, -127.f, 127.f)) & 0xffu; }
__device__ __forceinline__ u32x2 pack8_i8(const f32x4 a, const f32x4 b) {
    return (u32x2){q8(a[0]) | (q8(a[1]) << 8) | (q8(a[2]) << 16) | (q8(a[3]) << 24), q8(b[0]) | (q8(b[1]) << 8) | (q8(b[2]) << 16) | (q8(b[3]) << 24)}; }
__device__ __forceinline__ float bf_lo(unsigned w) { return __uint_as_float(w << 16); }
__device__ __forceinline__ float bf_hi(unsigned w) { return __uint_as_float(w & 0xffff0000u); }
__device__ __forceinline__ int rfl(int v) { return __builtin_amdgcn_readfirstlane(v); }
__device__ __forceinline__ float sigmoid_f(float x) { return __builtin_amdgcn_rcpf(1.0f + __expf(-x)); }
__device__ __forceinline__ float wave_sum(float v) {
#pragma unroll
    for (int o = 1; o < 64; o <<= 1) v += __shfl_xor(v, o);
    return v;
}
__device__ __forceinline__ int opaque_lane() { int l; asm volatile("v_mbcnt_lo_u32_b32 %0, -1, 0\n\tv_mbcnt_hi_u32_b32 %0, -1, %0" : "=v"(l)); return l; }
#define LDS_WAIT() asm volatile("s_waitcnt lgkmcnt(0)" ::: "memory")
#define VM_WAIT()  asm volatile("s_waitcnt vmcnt(0)" ::: "memory")

#define XB_TMO      128
#define XB_XCNT(j)  (256  + 64 * (j))
#define XB_XSUB(j)  (1280 + 64 * (j))
#define XB_XGEN(j)  (2304 + 64 * (j))
#define XB_TOP      3328
#define XB_TOPGEN   3392
#define XCD_BAR_WORDS 3456
#define XB_SPIN_CAP (1u << 22)

__device__ __forceinline__ unsigned xb_ld(unsigned* p)              { return __hip_atomic_load(p, __ATOMIC_RELAXED, __HIP_MEMORY_SCOPE_AGENT); }
__device__ __forceinline__ unsigned xb_add(unsigned* p, unsigned v) { return __hip_atomic_fetch_add(p, v, __ATOMIC_RELAXED, __HIP_MEMORY_SCOPE_AGENT); }
__device__ __forceinline__ unsigned xb_xcc_id() { return (unsigned)__builtin_amdgcn_s_getreg((3 << 11) | 20) & 0xFu; }
#define XB_SPIN(cond, bar) do { unsigned _sp = 0; while (cond) { __builtin_amdgcn_s_sleep(1); \
    if ((++_sp & 255u) == 0u) { if (xb_ld(&(bar)[XB_TMO])) break; if (_sp > XB_SPIN_CAP) { atomicAdd(&(bar)[XB_TMO], 1u); break; } } } } while (0)

struct XcdBarrier { unsigned* bar; unsigned x; volatile LAS unsigned* st; };

__device__ __forceinline__ XcdBarrier xcd_barrier_post(unsigned* bar, volatile LAS unsigned* st) {
    XcdBarrier b; b.bar = bar; b.x = xb_xcc_id(); b.st = st;
    if (threadIdx.x == 0) (void)xb_add(&bar[XB_XCNT(b.x)], 1u);
    return b;
}
__device__ __forceinline__ void xcd_barrier_complete(unsigned* bar, unsigned x, unsigned& nloc, unsigned& nx) {
    const unsigned G = gridDim.x * gridDim.y * gridDim.z;
    unsigned sum, cnt, mine, sp = 0u;
    for (;;) {
        sum = 0u; cnt = 0u; mine = 0u;
#pragma unroll
        for (unsigned j = 0; j < 16; ++j) { const unsigned c = xb_ld(&bar[XB_XCNT(j)]); sum += c; cnt += (c > 0u) ? 1u : 0u; mine = (j == x) ? c : mine; }
        if (sum == G) break;
        __builtin_amdgcn_s_sleep(1);
        if ((++sp & 255u) == 0u) { if (xb_ld(&bar[XB_TMO])) break; if (sp > XB_SPIN_CAP) { atomicAdd(&bar[XB_TMO], 1u); break; } }
    }
    nloc = mine > 0u ? mine : 1u; nx = cnt > 0u ? cnt : 1u;
}
__device__ __forceinline__ void xcd_barrier(const XcdBarrier& b) {
    asm volatile("s_waitcnt vmcnt(0)" ::: "memory");
    __syncthreads();
    if (threadIdx.x == 0) {
        unsigned* bar = b.bar;
        __builtin_amdgcn_s_waitcnt(0);
        unsigned nloc = b.st[0], nx = b.st[1];
        if (nloc == 0u) { xcd_barrier_complete(bar, b.x, nloc, nx); b.st[0] = nloc; b.st[1] = nx; }
        const unsigned old = xb_add(&bar[XB_XSUB(b.x)], 1u);
        const unsigned gen = old / nloc;
        if (old + 1u == (gen + 1u) * nloc) {
            __builtin_amdgcn_fence(__ATOMIC_RELEASE, "agent");
            asm volatile("s_waitcnt vmcnt(0)" ::: "memory");
            const unsigned og = xb_add(&bar[XB_TOP], 1u);
            const unsigned tg = og / nx;
            if (og + 1u == (tg + 1u) * nx) xb_add(&bar[XB_TOPGEN], 1u);
            else XB_SPIN(xb_ld(&bar[XB_TOPGEN]) == tg, bar);
            __builtin_amdgcn_fence(__ATOMIC_ACQUIRE, "agent");
            xb_add(&bar[XB_XGEN(b.x)], 1u);
            asm volatile("s_waitcnt vmcnt(0)" ::: "memory");
        } else {
            XB_SPIN(xb_ld(&bar[XB_XGEN(b.x)]) == gen, bar);
            __builtin_amdgcn_fence(__ATOMIC_ACQUIRE, "agent");
            asm volatile("s_waitcnt vmcnt(0)" ::: "memory");
        }
    }
    __syncthreads();
}

namespace gm {
constexpr int BM = 256, BK = 64, HALF = 128, HTB = HALF * BK * 2, NXCD = 8, WGM = 8;
__host__ __device__ __forceinline__ int lds_byte(int r, int c) { const int st = (r >> 4) * 2 + (c >> 5), rr = r & 15, cc = c & 31, ob = rr * 64 + cc * 2; return st * 1024 + (ob ^ (((ob >> 9) & 1) << 5)); }
__host__ __device__ __forceinline__ void stage_rc(int b, int& R, int& C) { const int st = b / 1024, sb = b % 1024, swz = sb ^ (((sb >> 9) & 1) << 5); R = (st >> 1) * 16 + swz / 64; C = (st & 1) * 32 + (swz % 64) / 2; }
__host__ __device__ __forceinline__ int perm32(int rho) { const int n = rho >> 4, i = rho & 15; return 8 * (i >> 2) + 4 * n + (i & 3); }

struct Unit { const char* a; const char* b; const char* b2; const char* info; const char* info1; int rows, orow, pn, split, half, seq; };

struct DenseOrder {
    int nM, nN, nwg, G, c; const char* A; const char* Bt; size_t aTile, bTile; int kofs_per_pn2; int kofsB_per_pm2 = 0;
    __device__ __forceinline__ bool next(int i, Unit& u) const {
        const long L = (long)i * G + c; if (L >= nwg) return false;
        int wgid = (int)L; { const int q = nwg / NXCD, r = nwg % NXCD, xcd = wgid % NXCD, off = wgid / NXCD; wgid = (xcd < r ? xcd * (q + 1) : r * (q + 1) + (xcd - r) * q) + off; }
        const int nig = WGM * nN, gid = wgid / nig, fm = gid * WGM, gsz = (nM - fm) < WGM ? (nM - fm) : WGM;
        const int pm = fm + ((wgid % nig) % gsz), pn = (wgid % nig) / gsz;
        u.a = A + (size_t)pm * aTile + (size_t)(pn >> 1) * kofs_per_pn2; u.b = Bt + (size_t)pn * bTile + (size_t)(pm >> 1) * kofsB_per_pm2; u.info = nullptr; u.info1 = nullptr; u.split = 256; u.half = 0; u.seq = i; u.rows = 256; u.orow = pm * 256; u.pn = pn; return true;
    }
};
struct MoeOrder {
    int nN, G, c, mode; const LAS int* tp; const LAS int* sbe; const LAS int* c0; const char* A; size_t aRow; const char* Bt; size_t bExp, bTile; const char* info;
    __device__ __forceinline__ bool next(int i, Unit& u) const {
        const int T = rfl(tp[32]);
        const int nfull = (((T * nN) / G) * G) / nN, nFullU = nfull * nN, nHalfU = (T - nfull) * 2 * nN;
        const long L = (long)i * G + c; if (L >= nFullU + nHalfU) return false;
        const int hf = L >= nFullU ? 1 : 0; const int nwg = hf ? nHalfU : nFullU;
        int wgid = (int)L - (hf ? nFullU : 0); { const int q = nwg / NXCD, r = nwg % NXCD, xcd = wgid % NXCD, off = wgid / NXCD; wgid = (xcd < r ? xcd * (q + 1) : r * (q + 1) + (xcd - r) * q) + off; }
        const int tix = wgid / nN, pn = wgid % nN, mtg = hf ? nfull + (tix >> 1) : tix, r0 = hf ? 128 * (tix & 1) : 0;
        const int ln = (int)__builtin_amdgcn_mbcnt_hi(~0u, __builtin_amdgcn_mbcnt_lo(~0u, 0u));
        const int tv = tp[ln < 32 ? ln : 32];
        const int e = __builtin_popcountll(__ballot(ln >= 1 && ln < 32 && tv <= mtg));
        const int mt = mtg - rfl(tp[e]); const int s0 = rfl(sbe[e]), s1 = rfl(sbe[e + 1]), n0 = rfl(c0[e]);
        const int cntE = mode == 0 ? (s1 - s0) : (mode == 1 ? n0 : (s1 - s0) - n0);
        const int rem = cntE - 256 * mt - r0, cap = hf ? 128 : 256;
        u.rows = rem < cap ? (rem < 0 ? 0 : rem) : cap; u.orow = s0 + (mode == 2 ? n0 : 0) + 256 * mt + r0; u.pn = pn; u.half = hf;
        const char* ib = info + ((size_t)e * CAP + (size_t)(256 * mt + r0)) * 16;
        if (mode == 0) { u.info = ib; u.info1 = ib + SI_RANK - (size_t)n0 * 16; u.split = n0 - 256 * mt - r0; }
        else { u.info = mode == 1 ? ib : ib + SI_RANK; u.info1 = u.info; u.split = 256; }
        u.b = Bt + (size_t)e * bExp + (size_t)pn * bTile;
        u.a = mode == 0 ? A : A + (size_t)u.orow * aRow;
        return true;
    }
};

struct PairOrder {
    int nN, G, c; const LAS int* tp; const LAS int* tph; const LAS int* ncl; const LAS int* ptab; const char* A; const char* Bt; size_t bExp, bTile; const char* info;
    __device__ __forceinline__ bool next(int i, Unit& u) const {
        const int TF = rfl(tp[NCLS]), TH = rfl(tph[NCLS]);
        const int nFullU = TF * nN, nHalfU = TH * nN;
        { const int cntc = (nFullU + nHalfU - c + G - 1) / G; if (i >= cntc) return false;
          const int nf = c < nFullU ? (nFullU - c + G - 1) / G : 0, nh = cntc - nf, m = nf < nh ? nf : nh, p = (c >> 6) & 1;
          if (i < 2 * m) { const bool full = (((i + p) & 1) == 0); i = full ? (i >> 1) : nf + (i >> 1); }
          else { const int k = m + (i - 2 * m); i = nf > nh ? k : nf + k; } }
        const long L = (long)i * G + c; if (L >= nFullU + nHalfU) return false;
        const int hf = L >= nFullU ? 1 : 0; const int nwg = hf ? nHalfU : nFullU;
        int wgid = (int)L - (hf ? nFullU : 0); { const int q = nwg / NXCD, r = nwg % NXCD, xcd = wgid % NXCD, off = wgid / NXCD; wgid = (xcd < r ? xcd * (q + 1) : r * (q + 1) + (xcd - r) * q) + off; }
        const int tix = wgid / nN, pn = wgid % nN;
        const LAS int* tb = hf ? tph : tp;
        const int ln = (int)__builtin_amdgcn_mbcnt_hi(~0u, __builtin_amdgcn_mbcnt_lo(~0u, 0u));
        const int tv0 = tb[ln], tv1 = tb[ln + 64 < NCLS ? ln + 64 : NCLS];
        const int cls = __builtin_popcountll(__ballot(ln >= 1 && tv0 <= tix)) + __builtin_popcountll(__ballot(ln + 64 < NCLS && tv1 <= tix));
        const int n = rfl(ncl[cls]), mt = hf ? (n >> 8) : tix - rfl(tb[cls]);
        const int rem = n - 256 * mt;
        u.rows = rem < 256 ? rem : 256; u.orow = 0; u.pn = pn; u.half = hf; u.split = 256;
        u.info = info + ((size_t)cls * CAP + (size_t)(256 * mt)) * 16; u.info1 = u.info;
        const int grp = cls / 28, pe = rfl(ptab[cls - 28 * grp]);
        u.b = Bt + (size_t)(8 * grp + (pe & 15)) * bExp + (size_t)pn * bTile; u.b2 = Bt + (size_t)(8 * grp + (pe >> 4)) * bExp + (size_t)pn * bTile;
        u.a = A;
        return true;
    }
};

template <class Epi, class Sched, bool INFO, bool GATHER, int AGM = 0, int QT = 0, bool PAIR = false>
__device__ __forceinline__ void gemm_phase(LAS unsigned char* lds, LAS unsigned char* linfo, const int K, const int lda, const Sched& S, const Epi& E, const int wid, const int ldb_ = 0) {
    const int lane = opaque_lane(), tid = wid * 64 + lane, wr = wid >> 2, wc = wid & 3, fr = lane & 15, fq = lane >> 4;
    const int nt = K / BK, ldb = ldb_ ? ldb_ : K;
    unsigned voffA[2][2], voffB[2]; int RA[2], CA[2];
#pragma unroll
    for (int i = 0; i < 2; ++i) { int R, C; stage_rc(tid * 16 + i * 8192, R, C); const int Rb = (R & ~31) + perm32(R & 31);
        RA[i] = R; CA[i] = C; voffB[i] = (unsigned)(Rb * ldb + C) * 2u;
        if (AGM == 1) { voffA[0][i] = (unsigned)(((C >> 4) * NROWS + R) * 32 + (C & 15) * 2); voffA[1][i] = voffA[0][i] + (unsigned)(HALF * 32); }
        else if (AGM == 2) { voffA[0][i] = (unsigned)(((C >> 3) * NROWS + R) * 16); voffA[1][i] = voffA[0][i] + (unsigned)(HALF * 16); }
        else { voffA[0][i] = (unsigned)(R * lda + C) * 2u; voffA[1][i] = (unsigned)((R + HALF) * lda + C) * 2u; } }
    const size_t kstep = (size_t)(BK * 2);
    const size_t kstepA = AGM == 1 ? (size_t)4 * NROWS * 32 : (AGM == 2 ? (size_t)8 * NROWS * 16 : kstep);
    const size_t hstep = (size_t)HALF * ldb * 2;
    const unsigned ldsw = (unsigned)wid * 1024u;
    const int aoff = lds_byte(wr * 64 + fr, fq * 8), boff = lds_byte(wc * 32 + fr, fq * 8);
#define G_SA(b, h) (((b) * 2 + (h)) * HTB)
#define G_SB(b, h) ((4 + (b) * 2 + (h)) * HTB)
#define G_STAGE(bufoff, gbase, voff) do { _Pragma("unroll") for (int _i = 0; _i < 2; ++_i) \
        __builtin_amdgcn_global_load_lds((const unsigned*)((const char*)(gbase) + (voff)[_i]), (LAS unsigned*)(lds + (bufoff) + ldsw + _i * 8192), 16, 0, 0); } while (0)
#define G_LDA(dst, b, h) do { if constexpr (QT == 1) { _Pragma("unroll") for (int m = 0; m < 4; ++m) { \
            const i32x4 _lo = *(const LAS i32x4*)(lds + G_SA(b, h) + aoff + m * 2048), _hi = *(const LAS i32x4*)(lds + G_SA(b, h) + aoff + m * 2048 + 1024); \
            dst##8[m] = __builtin_shufflevector(_lo, _hi, 0, 1, 2, 3, 4, 5, 6, 7); } } \
        else { _Pragma("unroll") for (int m = 0; m < 4; ++m) _Pragma("unroll") for (int k = 0; k < 2; ++k) dst[m][k] = *(const LAS s16x8*)(lds + G_SA(b, h) + aoff + m * 2048 + k * 1024); } } while (0)
#define G_LDB(dst, b, h) do { if constexpr (QT == 1) { _Pragma("unroll") for (int n = 0; n < 2; ++n) { \
            const i32x4 _lo = *(const LAS i32x4*)(lds + G_SB(b, h) + boff + n * 2048), _hi = *(const LAS i32x4*)(lds + G_SB(b, h) + boff + n * 2048 + 1024); \
            dst##8[n] = __builtin_shufflevector(_lo, _hi, 0, 1, 2, 3, 4, 5, 6, 7); } } \
        else { _Pragma("unroll") for (int n = 0; n < 2; ++n) _Pragma("unroll") for (int k = 0; k < 2; ++k) dst[n][k] = *(const LAS s16x8*)(lds + G_SB(b, h) + boff + n * 2048 + k * 1024); } } while (0)
#define G_MMA(ai, bj, At, Bt) do { __builtin_amdgcn_s_setprio(1); \
        if constexpr (QT == 1) { _Pragma("unroll") for (int m = 0; m < 4; ++m) _Pragma("unroll") for (int n = 0; n < 2; ++n) \
            asm volatile("v_mfma_scale_f32_16x16x128_f8f6f4 %0, %1, %2, %0, %3, %3 op_sel_hi:[0,0,0]" : "+v"(acc[ai][bj][m][n]) : "v"(Bt##8[n]), "v"(At##8[m]), "v"(sc1)); } \
        else { _Pragma("unroll") for (int m = 0; m < 4; ++m) _Pragma("unroll") for (int n = 0; n < 2; ++n) _Pragma("unroll") for (int k = 0; k < 2; ++k) { \
            if constexpr (QT == 2) acc[ai][bj][m][n] = __builtin_bit_cast(f32x4, __builtin_amdgcn_mfma_i32_16x16x64_i8(__builtin_bit_cast(i32x4, Bt[n][k]), __builtin_bit_cast(i32x4, At[m][k]), __builtin_bit_cast(i32x4, acc[ai][bj][m][n]), 0, 0, 0)); \
            else acc[ai][bj][m][n] = __builtin_amdgcn_mfma_f32_16x16x32_bf16(Bt[n][k], At[m][k], acc[ai][bj][m][n], 0, 0, 0); } } \
        __builtin_amdgcn_s_setprio(0); } while (0)
#define G_WAIT_V(n) asm volatile("s_waitcnt vmcnt(" #n ")" ::: "memory")
#define G_WAIT_L(n) asm volatile("s_waitcnt lgkmcnt(" #n ")" ::: "memory")
#define G_BAR __builtin_amdgcn_s_barrier()
#define G_SCHED __builtin_amdgcn_sched_barrier(0)
#define G_SETVOFF(buf, urows) do { _Pragma("unroll") for (int _h = 0; _h < 2; ++_h) _Pragma("unroll") for (int _i = 0; _i < 2; ++_i) { \
        const int _r = RA[_i] + _h * HALF; int _t = *(const LAS int*)(linfo + (buf) * 4096 + _r * 16); _t = (_r < (urows)) ? _t : 0; \
        voffA[_h][_i] = (unsigned)(_t * lda + CA[_i]) * 2u; } } while (0)
#define G_SETVOFF_P(buf, urows, second) do { _Pragma("unroll") for (int _h = 0; _h < 2; ++_h) _Pragma("unroll") for (int _i = 0; _i < 2; ++_i) { \
        const int _r = RA[_i] + _h * HALF; unsigned _t = *(const LAS unsigned*)(linfo + (buf) * 4096 + _r * 16); _t = (_r < (urows)) ? _t : 0u; \
        voffA[_h][_i] = (_t & 0x7fffffffu) * 1024u + (((_t >> 31) ^ (unsigned)(second)) << 9) + (unsigned)CA[_i] * 2u; } } while (0)
    Unit cur, nxt; int ui = 0, ib_cur = 0, ib_nxt = 1;
    const int tlk = nt >= 8 ? 2 : 0;
    if (!S.next(0, cur)) return;
    f32x4 acc[2][2][4][2];
#pragma unroll
    for (int a = 0; a < 2; ++a)
#pragma unroll
        for (int b = 0; b < 2; ++b)
#pragma unroll
            for (int m = 0; m < 4; ++m)
#pragma unroll
                for (int n = 0; n < 2; ++n) acc[a][b][m][n] = (f32x4){0.f, 0.f, 0.f, 0.f};
    const int sc1 = 0x7f7f7f7f;
    s16x8 At[4][2], B0[2][2], B1[2][2]; i32x8 At8[4], B08[2], B18[2];
    const char* cA = cur.a; const char* cB = cur.b; const char* cB2 = PAIR ? cur.b2 : cur.b; bool hfu = cur.half != 0;
    const int hnt = nt >> 1;
    if constexpr (INFO) {
        if (wid < 4) { const int r = wid * 64 + lane; __builtin_amdgcn_global_load_lds((const unsigned*)((r < cur.split ? cur.info : cur.info1) + r * 16), (LAS unsigned*)(linfo + wid * 1024), 16, 0, 0); }
        G_WAIT_V(0); G_BAR; asm volatile("" ::: "memory");
        if constexpr (PAIR) { G_SETVOFF_P(0, cur.rows, 0); } else if constexpr (GATHER) { G_SETVOFF(0, cur.rows); }
    }
    G_STAGE(G_SB(0, 0), cB, voffB); G_STAGE(G_SB(0, 1), cB + hstep, voffB); G_STAGE(G_SA(0, 0), cA, voffA[0]); G_STAGE(G_SA(0, 1), cA, voffA[1]);
    if (wr == 1) G_BAR;
    G_WAIT_V(2); G_BAR;
    G_STAGE(G_SB(1, 0), cB + kstep, voffB); G_STAGE(G_SA(1, 0), cA + kstepA, voffA[0]); G_STAGE(G_SB(1, 1), cB + hstep + kstep, voffB);
    G_WAIT_V(6); G_BAR;
    for (;;) {
        bool has_next = false; const char* nA = cA; const char* nB = cB; const char* nB2 = cB2;
#pragma unroll 1
        for (int t = 0; t < nt; t += 2) {
            const bool last = (t == nt - 2);
            if (t == tlk) { has_next = S.next(ui + 1, nxt); if (has_next) { nA = nxt.a; nB = nxt.b; if constexpr (PAIR) nB2 = nxt.b2; } }
            const char* a1; const char* a2; const char* b2;
            if constexpr (PAIR) { const int s1 = t + 1 >= hnt ? t + 1 - hnt : t + 1, s2 = t + 2 >= hnt ? t + 2 - hnt : t + 2;
                a1 = cA + (size_t)s1 * kstepA; a2 = last ? nA : cA + (size_t)s2 * kstepA; b2 = last ? nB : (t + 2 >= hnt ? cB2 : cB) + (size_t)s2 * kstep; }
            else { a1 = cA + (size_t)(t + 1) * kstepA; a2 = last ? nA : cA + (size_t)(t + 2) * kstepA; b2 = last ? nB : cB + (size_t)(t + 2) * kstep; }
            const char* a3 = a2 + kstepA; const char* b3 = b2 + kstep;
            if constexpr (INFO) { if (t == tlk && has_next && wid < 4) {
                const int r = wid * 64 + lane;
                __builtin_amdgcn_global_load_lds((const unsigned*)((r < nxt.split ? nxt.info : nxt.info1) + r * 16), (LAS unsigned*)(linfo + ib_nxt * 4096 + wid * 1024), 16, 0, 0); } }
            G_LDB(B0, 0, 0); G_LDB(B1, 0, 1); G_SCHED; G_LDA(At, 0, 0); G_STAGE(G_SA(1, 1), a1, voffA[1]);
            G_WAIT_V(8); G_WAIT_L(0); G_BAR; G_MMA(0, 0, At, B0); G_MMA(0, 1, At, B1); G_BAR; G_SCHED;
            if constexpr (PAIR) { if (last) { if (has_next) { G_SETVOFF_P(ib_nxt, nxt.rows, 0); } } else if (t + 2 == hnt) { G_SETVOFF_P(ib_cur, cur.rows, 1); } }
            else if constexpr (GATHER) { if (last && has_next) { G_SETVOFF(ib_nxt, nxt.rows); } }
            if (!hfu) { G_LDA(At, 0, 1); } G_STAGE(G_SB(0, 0), b2, voffB); G_STAGE(G_SB(0, 1), b2 + hstep, voffB); G_STAGE(G_SA(0, 0), a2, voffA[0]);
            G_WAIT_V(8); G_WAIT_L(0); G_BAR; if (!hfu) { G_MMA(1, 0, At, B0); G_MMA(1, 1, At, B1); } G_BAR; G_SCHED;
            G_LDB(B0, 1, 0); G_LDB(B1, 1, 1); G_SCHED; G_LDA(At, 1, 0); G_STAGE(G_SA(0, 1), a2, voffA[1]);
            G_WAIT_V(8); G_WAIT_L(0); G_BAR; G_MMA(0, 0, At, B0); G_MMA(0, 1, At, B1); G_BAR; G_SCHED;
            if (!hfu) { G_LDA(At, 1, 1); } G_STAGE(G_SB(1, 0), b3, voffB); G_STAGE(G_SB(1, 1), b3 + hstep, voffB); G_STAGE(G_SA(1, 0), a3, voffA[0]);
            G_WAIT_V(8); G_WAIT_L(0); G_BAR; if (!hfu) { G_MMA(1, 0, At, B0); G_MMA(1, 1, At, B1); } G_BAR; G_SCHED;
        }
        if (wr == 0) G_BAR;
        if constexpr (QT == 1) { asm volatile("s_nop 15\n\ts_nop 15" ::: "memory"); }
        E(acc, cur, wr, wc, fr, fq, linfo + ib_cur * 4096);
        if (!has_next) break;
#pragma unroll
        for (int a = 0; a < 2; ++a)
#pragma unroll
            for (int b = 0; b < 2; ++b)
#pragma unroll
                for (int m = 0; m < 4; ++m)
#pragma unroll
                    for (int n = 0; n < 2; ++n) acc[a][b][m][n] = (f32x4){0.f, 0.f, 0.f, 0.f};
        if constexpr (QT == 1) { asm volatile("s_nop 7" ::: "memory"); }
        cur = nxt; cA = nA; cB = nB; cB2 = nB2; hfu = cur.half != 0; ++ui; ib_cur = ib_nxt; ib_nxt = ib_nxt == 2 ? 0 : ib_nxt + 1;
        if (wr == 1) G_BAR;
    }
    G_WAIT_V(0);
    G_BAR;
#undef G_SA
#undef G_SB
#undef G_STAGE
#undef G_LDA
#undef G_LDB
#undef G_MMA
#undef G_WAIT_V
#undef G_WAIT_L
#undef G_BAR
#undef G_SCHED
#undef G_SETVOFF
#undef G_SETVOFF_P
}

typedef f32x4 Acc[2][2][4][2];
__device__ __forceinline__ u32x4 pack8(const f32x4 a, const f32x4 b) { u32x4 w; w.x = cvt_pk_bf16(a[0], a[1]); w.y = cvt_pk_bf16(a[2], a[3]); w.z = cvt_pk_bf16(b[0], b[1]); w.w = cvt_pk_bf16(b[2], b[3]); return w; }
__device__ __forceinline__ void unpack8(const u32x4 w, f32x4& a, f32x4& b) { a = (f32x4){bf_lo(w.x), bf_hi(w.x), bf_lo(w.y), bf_hi(w.y)}; b = (f32x4){bf_lo(w.z), bf_hi(w.z), bf_lo(w.w), bf_hi(w.w)}; }

struct EpiU {
    bf16_t* O; const LAS float* rtab; const LAS float* ctab; int gmaj;
    __device__ __forceinline__ void operator()(const Acc& acc, const Unit& u, int wr, int wc, int fr, int fq, LAS unsigned char*) const {
        const int row0 = u.orow + wr * 64 + fr, col0 = u.pn * 256 + wc * 32 + 8 * fq;
        const LAS float* rt = rtab + u.seq * 256 + wr * 64 + fr;
        f32x4 sc[2][2];
#pragma unroll
        for (int bj = 0; bj < 2; ++bj) { sc[bj][0] = *(const LAS f32x4*)(ctab + col0 + bj * HALF); sc[bj][1] = *(const LAS f32x4*)(ctab + col0 + bj * HALF + 4); }
#pragma unroll
        for (int ai = 0; ai < 2; ++ai)
#pragma unroll
            for (int m = 0; m < 4; ++m) { const int r = row0 + ai * HALF + m * 16; const float s = rt[ai * HALF + m * 16];
#pragma unroll
                for (int bj = 0; bj < 2; ++bj) { const int col = col0 + bj * HALF;
                    bf16_t* p = gmaj ? O + ((size_t)(col >> 4) * NROWS + r) * 16 + (col & 15) : O + (size_t)r * D + col;
                    const f32x4 v0 = __builtin_convertvector(__builtin_bit_cast(i32x4, acc[ai][bj][m][0]), f32x4) * sc[bj][0] * s, v1 = __builtin_convertvector(__builtin_bit_cast(i32x4, acc[ai][bj][m][1]), f32x4) * sc[bj][1] * s;
                    *(u32x4*)p = pack8(v0, v1); } }
    }
};
struct EpiGlu {
    bf16_t* H; unsigned char* H8; float sc;
    __device__ __forceinline__ void operator()(const Acc& acc, const Unit& u, int wr, int wc, int fr, int fq, LAS unsigned char*) const {
        const int row0 = u.orow + wr * 64 + fr, col0 = u.pn * 128 + wc * 32 + 8 * fq;
        u32x4 hv[2][4];
#pragma unroll
        for (int ai = 0; ai < 2; ++ai)
#pragma unroll
            for (int m = 0; m < 4; ++m) hv[ai][m] = *(const u32x4*)(H + (size_t)(row0 + ai * HALF + m * 16) * D + col0);
#pragma unroll
        for (int ai = 0; ai < 2; ++ai)
#pragma unroll
            for (int m = 0; m < 4; ++m) { bf16_t* p = H + (size_t)(row0 + ai * HALF + m * 16) * D + col0;
                f32x4 h0, h1; unpack8(hv[ai][m], h0, h1);
                const f32x4 v0 = acc[ai][0][m][0] * sc, v1 = acc[ai][0][m][1] * sc, g0 = acc[ai][1][m][0] * sc, g1 = acc[ai][1][m][1] * sc;
#pragma unroll
                for (int j = 0; j < 4; ++j) { h0[j] += v0[j] * sigmoid_f(g0[j]); h1[j] += v1[j] * sigmoid_f(g1[j]); }
                *(u32x4*)p = pack8(h0, h1);
                *(u32x2*)(H8 + (size_t)(row0 + ai * HALF + m * 16) * D + col0) = (u32x2){cvt_pk4_fp8(h0[0], h0[1], h0[2], h0[3]), cvt_pk4_fp8(h1[0], h1[1], h1[2], h1[3])}; }
    }
};
struct EpiGrp {
    bf16_t* H; const float* scale; unsigned char* H8;
    __device__ __forceinline__ void operator()(const Acc& acc, const Unit& u, int wr, int wc, int fr, int fq, LAS unsigned char*) const {
        const int row0 = u.orow + wr * 64 + fr, col0 = u.pn * 256 + wc * 32 + 8 * fq;
        f32x4 sc[2][2];
#pragma unroll
        for (int bj = 0; bj < 2; ++bj) { sc[bj][0] = *(const f32x4*)(scale + col0 + bj * HALF); sc[bj][1] = *(const f32x4*)(scale + col0 + bj * HALF + 4); }
#pragma unroll
        for (int ai = 0; ai < 2; ++ai) {
            u32x4 hv[4][2];
#pragma unroll
            for (int m = 0; m < 4; ++m)
#pragma unroll
                for (int bj = 0; bj < 2; ++bj) hv[m][bj] = *(const u32x4*)(H + (size_t)(row0 + ai * HALF + m * 16) * D + col0 + bj * HALF);
#pragma unroll
            for (int m = 0; m < 4; ++m) { bf16_t* p = H + (size_t)(row0 + ai * HALF + m * 16) * D + col0;
#pragma unroll
                for (int bj = 0; bj < 2; ++bj) { f32x4 h0, h1; unpack8(hv[m][bj], h0, h1);
                    h0 += acc[ai][bj][m][0] * sc[bj][0]; h1 += acc[ai][bj][m][1] * sc[bj][1];
                    *(u32x4*)(p + bj * HALF) = pack8(h0, h1);
                    *(u32x2*)(H8 + (size_t)(row0 + ai * HALF + m * 16) * D + col0 + bj * HALF) = (u32x2){cvt_pk4_fp8(h0[0], h0[1], h0[2], h0[3]), cvt_pk4_fp8(h1[0], h1[1], h1[2], h1[3])}; } }
        }
    }
};
struct EpiGU {
    bf16_t* HID;
    __device__ __forceinline__ void operator()(const Acc& acc, const Unit& u, int wr, int wc, int fr, int fq, LAS unsigned char* linfo) const {
        const int col0 = u.pn * 128 + wc * 32 + 8 * fq;
#pragma unroll
        for (int ai = 0; ai < 2; ++ai)
#pragma unroll
            for (int m = 0; m < 4; ++m) { const int rl = ai * HALF + wr * 64 + m * 16 + fr;
                const f32x4 inf = *(const LAS f32x4*)(linfo + rl * 16); const float w = inf[1], rs = inf[2] * (1.0f / 32.0f);
                f32x4 o0, o1;
#pragma unroll
                for (int j = 0; j < 4; ++j) { const float ga = acc[ai][0][m][0][j] * rs, gb = acc[ai][0][m][1][j] * rs;
                    o0[j] = __builtin_amdgcn_fmed3f(w * ga * sigmoid_f(ga) * (acc[ai][1][m][0][j] * rs), -25.f, 25.f);
                    o1[j] = __builtin_amdgcn_fmed3f(w * gb * sigmoid_f(gb) * (acc[ai][1][m][1][j] * rs), -25.f, 25.f); }
                if (rl < u.rows) *(u32x2*)((unsigned char*)HID + ((size_t)__float_as_int(inf[0]) * 2 + (rl >= u.split ? 1 : 0)) * DE + col0) = (u32x2){cvt_pk4_fp8(o0[0] * 16.f, o0[1] * 16.f, o0[2] * 16.f, o0[3] * 16.f), cvt_pk4_fp8(o1[0] * 16.f, o1[1] * 16.f, o1[2] * 16.f, o1[3] * 16.f)}; }
    }
};
template <bool SS>
struct EpiAdd {
    bf16_t* H; float* SSP; float ascale; unsigned char* HI8;
    __device__ __forceinline__ void operator()(const Acc& acc, const Unit& u, int wr, int wc, int fr, int fq, LAS unsigned char* linfo) const {
        const int col0 = u.pn * 256 + wc * 32 + 8 * fq;
        u32x4 hv[2][4][2]; int tok[2][4];
#pragma unroll
        for (int ai = 0; ai < 2; ++ai)
#pragma unroll
            for (int m = 0; m < 4; ++m) { const int rl = ai * HALF + wr * 64 + m * 16 + fr; tok[ai][m] = *(const LAS int*)(linfo + rl * 16) & 0x7fffffff;
                hv[ai][m][0] = (u32x4){0u, 0u, 0u, 0u}; hv[ai][m][1] = hv[ai][m][0];
                if (rl < u.rows) { const bf16_t* p = H + (size_t)tok[ai][m] * D + col0; hv[ai][m][0] = *(const u32x4*)p; hv[ai][m][1] = *(const u32x4*)(p + HALF); } }
#pragma unroll
        for (int ai = 0; ai < 2; ++ai)
#pragma unroll
            for (int m = 0; m < 4; ++m) { const int rl = ai * HALF + wr * 64 + m * 16 + fr; const bool valid = rl < u.rows; float ss = 0.f;
                if (SS) tok[ai][m] = *(const LAS int*)(linfo + rl * 16) & 0x7fffffff;
#pragma unroll
                for (int bj = 0; bj < 2; ++bj) { f32x4 h0, h1; unpack8(hv[ai][m][bj], h0, h1); h0 += acc[ai][bj][m][0] * ascale; h1 += acc[ai][bj][m][1] * ascale;
                    if (SS) ss += (h0[0] * h0[0] + h0[1] * h0[1]) + (h0[2] * h0[2] + h0[3] * h0[3]) + (h1[0] * h1[0] + h1[1] * h1[1]) + (h1[2] * h1[2] + h1[3] * h1[3]);
                    if (valid) { *(u32x4*)(H + (size_t)tok[ai][m] * D + col0 + bj * HALF) = pack8(h0, h1);
                        if (SS && HI8) { const float qs = *(const LAS float*)(linfo + rl * 16 + 8) * (127.0f / QCLIP); *(u32x2*)(HI8 + (size_t)tok[ai][m] * D + col0 + bj * HALF) = pack8_i8(h0 * qs, h1 * qs); } } }
                if (SS) { ss += __shfl_xor(ss, 16); ss += __shfl_xor(ss, 32); if (valid && fq == 0) SSP[(size_t)tok[ai][m] * 32 + u.pn * 4 + wc] = ss; } }
    }
};
struct EpiDn {
    bf16_t* Y; unsigned* AM = nullptr;
    __device__ __forceinline__ void operator()(const Acc& acc, const Unit& u, int wr, int wc, int fr, int fq, LAS unsigned char*) const {
        const int col0 = u.pn * 256 + wc * 32 + 8 * fq;
#pragma unroll
        for (int ai = 0; ai < 2; ++ai)
#pragma unroll
            for (int m = 0; m < 4; ++m) { const int rl = ai * HALF + wr * 64 + m * 16 + fr;
                if (rl < u.rows) { bf16_t* p = Y + (size_t)(u.orow + rl) * D + col0;
#pragma unroll
                    for (int bj = 0; bj < 2; ++bj) *(u32x4*)(p + bj * HALF) = pack8(acc[ai][bj][m][0], acc[ai][bj][m][1]); }
                if (AM) { f32x4 mx = __builtin_elementwise_max(__builtin_elementwise_max(__builtin_elementwise_abs(acc[ai][0][m][0]), __builtin_elementwise_abs(acc[ai][0][m][1])),
                                                            __builtin_elementwise_max(__builtin_elementwise_abs(acc[ai][1][m][0]), __builtin_elementwise_abs(acc[ai][1][m][1])));
                    float mv = fmaxf(fmaxf(mx[0], mx[1]), fmaxf(mx[2], mx[3])); mv = fmaxf(mv, __shfl_xor(mv, 16)); mv = fmaxf(mv, __shfl_xor(mv, 32));
                    if (fq == 0 && rl < u.rows) atomicMax(AM + u.orow + rl, __float_as_uint(mv)); } }
    }
};
}


template <int KIND>
__device__ __forceinline__ void meta_gemm(LAS unsigned char* lds, const bf16_t* W, int K, int wrow0, int wrow1, const bf16_t* A, bf16_t* O, const float* aux, int cb, int wave, int lane, int gmaj = 0, unsigned char* H8 = nullptr, const float* ssp = nullptr) {
    const int m = lane & 15, q = lane >> 4, kw = K >> 3, nks = kw >> 5;
    f32x4 acc = (f32x4){0.f, 0.f, 0.f, 0.f}, acc2 = acc;
    const bf16_t* wp = W + (size_t)(wrow0 + m) * K + kw * wave + 8 * q;
    const bf16_t* wp2 = W + (size_t)(wrow1 + m) * K + kw * wave + 8 * q;
    const bf16_t* ap = A + (size_t)m * D + kw * wave + 8 * q;
#pragma unroll
    for (int ks = 0; ks < 8; ++ks) if (ks < nks) {
        const int kk = kw * wave + 32 * ks + 8 * q;
        union { u32x4 u; s16x8 s; } a, b, a2; a.u = *(const u32x4*)(wp + 32 * ks);
        b.u = (KIND == 1) ? *(const u32x4*)(A + ((size_t)(kk >> 4) * 16 + m) * 16 + (kk & 15)) : *(const u32x4*)(ap + 32 * ks);
        acc = __builtin_amdgcn_mfma_f32_16x16x32_bf16(a.s, b.s, acc, 0, 0, 0);
        if (KIND == 1) { a2.u = *(const u32x4*)(wp2 + 32 * ks); acc2 = __builtin_amdgcn_mfma_f32_16x16x32_bf16(a2.s, b.s, acc2, 0, 0, 0); }
    }
    LAS f32x4* red = (LAS f32x4*)lds;
    red[wave * 64 + lane] = acc; if (KIND == 1) red[512 + wave * 64 + lane] = acc2;
    __syncthreads();
    if (wave == 0) {
        f32x4 v = red[lane], g = (f32x4){0.f, 0.f, 0.f, 0.f};
#pragma unroll
        for (int w = 1; w < 8; ++w) v += red[w * 64 + lane];
        if (KIND == 1) { g = red[512 + lane];
#pragma unroll
            for (int w = 1; w < 8; ++w) g += red[512 + w * 64 + lane]; }
        const int col = 16 * cb + 4 * q; bf16_t* op = O + (size_t)(NREAL + m) * D + col;
        if (KIND == 0) { float s;
            if (ssp) { const f32x4* pp = (const f32x4*)(ssp + (size_t)(NREAL + m) * 32); f32x4 a = pp[0];
#pragma unroll
                for (int k = 1; k < 8; ++k) a += pp[k];
                s = rsqrtf(((a[0] + a[1]) + (a[2] + a[3])) * (1.0f / D) + RMS_EPS); }
            else s = aux[NREAL + m];
            bf16_t* up = gmaj ? O + ((size_t)cb * NROWS + NREAL + m) * 16 + 4 * q : op;
            *(u32x2*)up = (u32x2){cvt_pk_bf16(v[0] * s, v[1] * s), cvt_pk_bf16(v[2] * s, v[3] * s)}; }
        else { const u32x2 hv = *(const u32x2*)op; f32x4 h = (f32x4){bf_lo(hv.x), bf_hi(hv.x), bf_lo(hv.y), bf_hi(hv.y)};
            if (KIND == 1) {
#pragma unroll
                for (int i = 0; i < 4; ++i) h[i] += v[i] * sigmoid_f(g[i]); }
            else h += v * *(const f32x4*)(aux + col);
            *(u32x2*)op = (u32x2){cvt_pk_bf16(h[0], h[1]), cvt_pk_bf16(h[2], h[3])};
            *(unsigned*)(H8 + (size_t)(NREAL + m) * D + col) = cvt_pk4_fp8(h[0], h[1], h[2], h[3]); }
    }
    __syncthreads();
}
struct Params { const float* in[25]; float* out; unsigned char* ws; int ph_lo, ph_hi; };
enum { I_X = 0, I_META, I_NMIX, I_NFFN, I_NFIN, I_S5WIN, I_ARE, I_AIM, I_LOGDT, I_BRE, I_BIM, I_CRE, I_CIM, I_S5D, I_S5GLU, I_PWIN, I_PGRP, I_PSCALE,
       I_WC, I_BC, I_WF, I_BF, I_WG, I_WU, I_WD };

struct ConvDesc { const float* w; const float* gain; unsigned char* dst; unsigned char* dst2; int ldw, Kd, kind, off, n0, esz; float wscale; };
__device__ __forceinline__ void conv_load(const ConvDesc& d, f32x4 (&v)[16], int lane) {
#pragma unroll
    for (int it = 0; it < 16; ++it) { const int kk = 4 * it + (lane >> 4), n4 = (lane & 15) * 4; v[it] = *(const f32x4*)(d.w + (size_t)kk * d.ldw + n4); }
}
__device__ __forceinline__ void conv_store(const ConvDesc& d, const f32x4 (&v)[16], LAS float* scr, int lane) {
    const int c = lane & 7;
    f32x4 g0 = (f32x4){1.f, 1.f, 1.f, 1.f}, g1 = g0;
    if (d.gain) { g0 = *(const f32x4*)(d.gain + 8 * c); g1 = *(const f32x4*)(d.gain + 8 * c + 4); }
#pragma unroll
    for (int it = 0; it < 16; ++it) { const int kk = 4 * it + (lane >> 4), n4 = (lane & 15) * 4;
        LAS float* s = scr + kk * 65 + n4; s[0] = v[it][0]; s[1] = v[it][1]; s[2] = v[it][2]; s[3] = v[it][3]; }
    LDS_WAIT();
#pragma unroll
    for (int j = 0; j < 8; ++j) { const int nl = (lane >> 3) + 8 * j; const LAS float* s = scr + (8 * c) * 65 + nl;
        const float x0 = s[0] * g0[0], x1 = s[65] * g0[1], x2 = s[130] * g0[2], x3 = s[195] * g0[3], x4 = s[260] * g1[0], x5 = s[325] * g1[1], x6 = s[390] * g1[2], x7 = s[455] * g1[3];
        const int n = d.n0 + nl;
        const int row = d.kind == 0 ? n + d.off : (d.kind == 1 ? ((n & 2047) >> 7) * 256 + (n >> 11) * 128 + (n & 127) : (n >> 7) * 256 + d.off + (n & 127));
        if (d.esz == 2) { u32x4 o; o.x = cvt_pk_bf16(x0, x1); o.y = cvt_pk_bf16(x2, x3); o.z = cvt_pk_bf16(x4, x5); o.w = cvt_pk_bf16(x6, x7); *(u32x4*)(d.dst + ((size_t)row * d.Kd + 8 * c) * 2) = o;
            if (d.dst2) *(u32x2*)(d.dst2 + (size_t)row * d.Kd + 8 * c) = (u32x2){cvt_pk4_fp8(x0 * 32.f, x1 * 32.f, x2 * 32.f, x3 * 32.f), cvt_pk4_fp8(x4 * 32.f, x5 * 32.f, x6 * 32.f, x7 * 32.f)}; }
        else { const float ws_ = d.wscale; *(u32x2*)(d.dst + (size_t)row * d.Kd + 8 * c) = (u32x2){cvt_pk4_fp8(x0 * ws_, x1 * ws_, x2 * ws_, x3 * ws_), cvt_pk4_fp8(x4 * ws_, x5 * ws_, x6 * ws_, x7 * ws_)}; } }
    LDS_WAIT();
}
__device__ __forceinline__ void conv_store_i8(const ConvDesc& d, const f32x4 (&v)[16], LAS float* scr, int lane, const unsigned* am) {
    const int c = lane & 7;
    f32x4 g0 = (f32x4){1.f, 1.f, 1.f, 1.f}, g1 = g0;
    if (d.gain) { g0 = *(const f32x4*)(d.gain + 8 * c); g1 = *(const f32x4*)(d.gain + 8 * c + 4); }
#pragma unroll
    for (int it = 0; it < 16; ++it) { const int kk = 4 * it + (lane >> 4), n4 = (lane & 15) * 4;
        LAS float* s = scr + kk * 65 + n4; s[0] = v[it][0]; s[1] = v[it][1]; s[2] = v[it][2]; s[3] = v[it][3]; }
    LDS_WAIT();
#pragma unroll
    for (int j = 0; j < 8; ++j) { const int nl = (lane >> 3) + 8 * j; const LAS float* s = scr + (8 * c) * 65 + nl; const int n = d.n0 + nl;
        const float qs = 127.0f / fmaxf(__uint_as_float(am[n]), 1e-30f);
        const f32x4 a = (f32x4){s[0] * g0[0], s[65] * g0[1], s[130] * g0[2], s[195] * g0[3]} * qs, b = (f32x4){s[260] * g1[0], s[325] * g1[1], s[390] * g1[2], s[455] * g1[3]} * qs;
        *(u32x2*)(d.dst + (size_t)n * d.Kd + 8 * c) = pack8_i8(a, b); }
    LDS_WAIT();
}
constexpr int CV_WIN = 2 * 1024, CV_GLU = 2 * 2048, CV_GRP = 8 * 64, CV_GT = 128 * 256, CV_UP = 128 * 256, CV_DN = 128 * 256;
constexpr int CV_ITEMS = CV_WIN + CV_GLU + CV_GRP + CV_GT + CV_UP + CV_DN;
__device__ __forceinline__ bool conv_decode(const Params& P, int it, ConvDesc& d) {
    if (it >= CV_ITEMS) return false;
    unsigned char* ws = P.ws; int r = it; const float* W; const float* gain = nullptr; bf16_t* dst; unsigned char* dst2 = nullptr; int ldw, Kd, kind = 0, off = 0, kb, nb, esz = 2; float wscale = 1.0f;
    if (r < CV_WIN) { const int i = (r >> 10) * 2, rr = r & 1023; kb = rr >> 5; nb = rr & 31;
        W = (i & 1) ? P.in[I_PWIN] + (size_t)(i >> 1) * D * D : P.in[I_S5WIN] + (size_t)(i >> 1) * D * D; ldw = D; gain = P.in[I_NMIX] + i * D; dst = (bf16_t*)(ws + WS_WIN) + (size_t)i * D * D; Kd = D; }
    else if ((r -= CV_WIN) < CV_GLU) { const int j = r >> 11, rr = r & 2047; kb = rr >> 6; nb = rr & 63;
        W = P.in[I_S5GLU] + (size_t)j * D * 4096; ldw = 4096; dst = (bf16_t*)(ws + WS_GLU) + (size_t)j * 4096 * D; dst2 = ws + WS_GLU8 + (size_t)j * 4096 * D; Kd = D; kind = 1; }
    else if ((r -= CV_GLU) < CV_GRP) { const int m = r >> 6, rr = r & 63; kb = rr >> 3; nb = rr & 7;
        W = P.in[I_PGRP] + (size_t)m * 512 * 512; ldw = 512; dst = (bf16_t*)(ws + WS_GRP) + (size_t)(m >> 2) * D * 512; Kd = 512; off = (m & 3) * 512; }
    else if ((r -= CV_GRP) < CV_GT) { const int m = r >> 8, rr = r & 255; kb = rr >> 3; nb = rr & 7;
        W = P.in[I_WG] + (size_t)m * D * DE; ldw = DE; gain = P.in[I_NFFN] + (m >> 5) * D; dst = (bf16_t*)(ws + WS_GU + (size_t)m * 1024 * D); Kd = D; kind = 2; esz = 1; wscale = 32.0f; }
    else if ((r -= CV_GT) < CV_UP) { const int m = r >> 8, rr = r & 255; kb = rr >> 3; nb = rr & 7;
        W = P.in[I_WU] + (size_t)m * D * DE; ldw = DE; gain = P.in[I_NFFN] + (m >> 5) * D; dst = (bf16_t*)(ws + WS_GU + (size_t)m * 1024 * D); Kd = D; kind = 2; off = 128; esz = 1; wscale = 32.0f; }
    else { r -= CV_UP; const int m = r >> 8, rr = r & 255; kb = rr >> 5; nb = rr & 31;
        W = P.in[I_WD] + (size_t)m * DE * D; ldw = D; dst = (bf16_t*)(ws + WS_DN + (size_t)m * D * DE); Kd = DE; esz = 1; wscale = 16.0f; }
    d.w = W + (size_t)(kb * 64) * ldw + nb * 64; d.gain = gain ? gain + kb * 64 : nullptr; d.dst = (unsigned char*)dst + (size_t)(kb * 64) * esz; d.dst2 = dst2 ? dst2 + kb * 64 : nullptr; d.esz = esz; d.wscale = wscale; d.ldw = ldw; d.Kd = Kd; d.kind = kind; d.off = off; d.n0 = nb * 64;
    return true;
}

__device__ __forceinline__ void s5_tables(const Params& P, LAS unsigned char* lds, int wave, int lane);
__device__ __forceinline__ void phase0(const Params& P, LAS unsigned char* lds, int wave, int lane) {
    unsigned char* ws = P.ws;
    const int G = gridDim.x, gw = blockIdx.x * NWAVES + wave, NGW = G * NWAVES;
    const int gt = blockIdx.x * NTHR + wave * 64 + lane, NGT = G * NTHR;
    {
        bf16_t* H = (bf16_t*)(ws + WS_H); float* RS = (float*)(ws + WS_RSTD);
        float* RQ = (float*)(ws + WS_RQ); unsigned char* HI8 = ws + WS_HI8;
        for (int row = gw; row < NROWS; row += NGW) {
            const float* src = row < NREAL ? P.in[I_X] + (size_t)row * D : P.in[I_META] + (size_t)(row - NREAL) * D;
            float ss = 0.f; f32x4 va[4], vb[4];
#pragma unroll
            for (int j = 0; j < 4; ++j) { const int c = lane * 8 + 512 * j; const f32x4 a = *(const f32x4*)(src + c), b = *(const f32x4*)(src + c + 4); va[j] = a; vb[j] = b;
                ss += (a[0] * a[0] + a[1] * a[1]) + (a[2] * a[2] + a[3] * a[3]) + (b[0] * b[0] + b[1] * b[1]) + (b[2] * b[2] + b[3] * b[3]);
                *(u32x4*)(H + (size_t)row * D + c) = gm::pack8(a, b); }
            ss = wave_sum(ss);
            const float rs = rsqrtf(ss * (1.0f / D) + RMS_EPS), qs = rs * (127.0f / QCLIP);
            if (lane == 0) { RS[row] = rs; RQ[row] = rs; }
#pragma unroll
            for (int j = 0; j < 4; ++j) *(u32x2*)(HI8 + (size_t)row * D + lane * 8 + 512 * j) = pack8_i8(va[j] * qs, vb[j] * qs);
        }
    }
    {
        u32x4* RT = (u32x4*)(ws + WS_RT);
        for (int id = gt; id < 4 * 64 * 3 * 64; id += NGT) {
            const int ln = id & 63, nb = (id >> 6) % 3, ks = (id / 192) & 63, i = id / (192 * 64);
            const int col = 16 * nb + (ln & 15), kb = 32 * ks + 8 * (ln >> 4);
            float v[8];
#pragma unroll
            for (int jj = 0; jj < 8; ++jj) { const int k = kb + jj; float w = 0.f;
                if (col < 4) w = P.in[I_WC][((size_t)i * D + k) * 4 + col]; else if (col < 36) w = P.in[I_WF][((size_t)i * D + k) * 32 + (col - 4)];
                v[jj] = w * P.in[I_NFFN][i * D + k]; }
            u32x4 o; o.x = cvt_pk_bf16(v[0], v[1]); o.y = cvt_pk_bf16(v[2], v[3]); o.z = cvt_pk_bf16(v[4], v[5]); o.w = cvt_pk_bf16(v[6], v[7]);
            RT[id] = o;
        }
    }
    {
        bf16_t* WO = (bf16_t*)(ws + WS_WINO);
        for (int id = gt; id < 2 * D * (D / 8); id += NGT) {
            const int n8 = id & 255, k = (id >> 8) & 2047, j = id >> 19;
            const float* src = P.in[I_PWIN] + ((size_t)j * D + k) * D + n8 * 8; const float gs = P.in[I_NMIX][(2 * j + 1) * D + k];
            const f32x4 a = *(const f32x4*)src * gs, b = *(const f32x4*)(src + 4) * gs;
            *(u32x4*)(WO + ((size_t)j * D + k) * D + n8 * 8) = gm::pack8(a, b);
        }
    }
    {
        unsigned* AM = (unsigned*)ws + CW_AM; const int tid = wave * 64 + lane;
        for (int it = blockIdx.x; it < 64; it += G) {
            const int jl = it >> 5, kb = it & 31, i = 2 * jl; const float* W = P.in[I_S5WIN] + (size_t)jl * D * D + (size_t)kb * 64 * D + tid * 4; const float* gp = P.in[I_NMIX] + i * D + kb * 64;
            f32x4 mx = (f32x4){0.f, 0.f, 0.f, 0.f};
#pragma unroll 8
            for (int k = 0; k < 64; ++k) { const f32x4 v = *(const f32x4*)(W + (size_t)k * D) * gp[k]; mx = __builtin_elementwise_max(mx, __builtin_elementwise_abs(v)); }
#pragma unroll
            for (int c = 0; c < 4; ++c) atomicMax(AM + i * D + tid * 4 + c, __float_as_uint(mx[c]));
        }
    }
    s5_tables(P, lds, wave, lane);
    {
        LAS float* scr = (LAS float*)(lds + LDS_STAGE) + wave * (64 * 65);
        ConvDesc da, db; f32x4 va[16], vb[16];
        int it = gw; bool ha = conv_decode(P, it, da);
        if (ha) conv_load(da, va, lane);
        while (ha) {
            const bool hb = conv_decode(P, it + NGW, db);
            if (hb) conv_load(db, vb, lane);
            conv_store(da, va, scr, lane);
            if (!hb) break;
            it += 2 * NGW;
            ha = conv_decode(P, it, da);
            if (ha) conv_load(da, va, lane);
            conv_store(db, vb, scr, lane);
        }
    }
}

__device__ __forceinline__ void s5_tables(const Params& P, LAS unsigned char* lds, int wave, int lane) {
    unsigned char* ws = P.ws; const int tid = wave * 64 + lane;
    LAS float* pwr = (LAS float*)lds; LAS float* pwi = pwr + 576; LAS float* bbr = pwi + 576; LAS float* bbi = bbr + 1024;
    LAS float* ccr = bbi + 1024; LAS float* cci = ccr + 1024; LAS float* Kt = cci + 1024; LAS float* dk = Kt + 2048;
    for (int bj = blockIdx.x; bj < 2 * NG; bj += gridDim.x) {
        const int j = bj >> 7, g = bj & 127;
        __syncthreads();
        if (tid < 64) {
            const int s = tid;
            const double dt = exp((double)P.in[I_LOGDT][j * NG + g]);
            const double lr = (double)P.in[I_ARE][(j * NG + g) * NST + s], li = (double)P.in[I_AIM][(j * NG + g) * NST + s];
            const double mag = exp(lr * dt), abr = mag * cos(li * dt), abi = mag * sin(li * dt);
            const double den = lr * lr + li * li, nr = abr - 1.0, ni = abi;
            const double cr = (nr * lr + ni * li) / den, ci = (ni * lr - nr * li) / den;
            double pr = 1.0, pi = 0.0;
            for (int k = 0; k <= 8; ++k) { pwr[k * 64 + s] = (float)pr; pwi[k * 64 + s] = (float)pi; const double t = pr * abr - pi * abi; pi = pr * abi + pi * abr; pr = t; }
            const double magL = exp(lr * dt * CL), alr = magL * cos(li * dt * CL), ali = magL * sin(li * dt * CL);
            float* TA = (float*)(ws + WS_S5A); float* TL = (float*)(ws + WS_S5L);
            TA[((j * NG + g) * 2 + 0) * NST + s] = pwr[8 * 64 + s]; TA[((j * NG + g) * 2 + 1) * NST + s] = pwi[8 * 64 + s];
            TL[((j * NG + g) * 2 + 0) * NST + s] = (float)alr; TL[((j * NG + g) * 2 + 1) * NST + s] = (float)ali;
            { const f32x4* brp = (const f32x4*)(P.in[I_BRE] + ((size_t)(j * NG + g) * NST + s) * 16); const f32x4* bip = (const f32x4*)(P.in[I_BIM] + ((size_t)(j * NG + g) * NST + s) * 16);
              f32x4 brv[4], biv[4];
#pragma unroll
              for (int h4 = 0; h4 < 4; ++h4) { brv[h4] = brp[h4]; biv[h4] = bip[h4]; }
#pragma unroll
              for (int h = 0; h < 16; ++h) { const double br = (double)brv[h >> 2][h & 3], bi = (double)biv[h >> 2][h & 3];
                  bbr[s * 16 + h] = (float)(cr * br - ci * bi); bbi[s * 16 + h] = (float)(cr * bi + ci * br); } }
        }
        if (tid >= 64 && tid < 80) dk[tid - 64] = P.in[I_S5D][(size_t)j * D + 16 * g + tid - 64];
        for (int e = tid; e < 1024; e += NTHR) { ccr[e] = P.in[I_CRE][(size_t)(j * NG + g) * 1024 + e]; cci[e] = P.in[I_CIM][(size_t)(j * NG + g) * 1024 + e]; }
        __syncthreads();
        {
            const int tau0 = tid >> 8, h = (tid >> 4) & 15, hp = tid & 15; float acc4[4] = {0.f, 0.f, 0.f, 0.f};
            for (int s = 0; s < 64; ++s) { const float c_r = ccr[h * 64 + s], c_i = cci[h * 64 + s], b_r = bbr[s * 16 + hp], b_i = bbi[s * 16 + hp];
                const float cb_r = c_r * b_r - c_i * b_i, cb_i = c_r * b_i + c_i * b_r;
#pragma unroll
                for (int k = 0; k < 4; ++k) acc4[k] += cb_r * pwr[(tau0 + 2 * k) * 64 + s] - cb_i * pwi[(tau0 + 2 * k) * 64 + s]; }
#pragma unroll
            for (int k = 0; k < 4; ++k) Kt[((tau0 + 2 * k) << 8) | (tid & 255)] = acc4[k];
        }
        __syncthreads();
        u32x4* T = (u32x4*)(ws + WS_S5T) + (size_t)(j * NG + g) * 3 * 2048;
        for (int f = tid; f < 3 * 2048; f += NTHR) {
            const int ln = f & 63, ks = (f >> 6) & 3, rb = (f >> 8) & 7, mat = f >> 11, m = ln & 15, qa = ln >> 4;
            float v[8];
#pragma unroll
            for (int jj = 0; jj < 8; ++jj) {
                float val;
                if (mat == 0) { const int part = rb >> 2, s = 16 * (rb & 3) + m, i = 2 * ks + (qa >> 1), hp = 8 * (qa & 1) + jj;
                    const float p_r = pwr[(7 - i) * 64 + s], p_i = pwi[(7 - i) * 64 + s], b_r = bbr[s * 16 + hp], b_i = bbi[s * 16 + hp];
                    val = part ? (p_r * b_i + p_i * b_r) : (p_r * b_r - p_i * b_i); }
                else if (mat == 1) { const int jstep = rb, h = m, rbs = 2 * ks + (jj >> 2), part = rbs >> 2, s = 16 * (rbs & 3) + 4 * qa + (jj & 3);
                    const float c_r = ccr[h * 64 + s], c_i = cci[h * 64 + s], p_r = pwr[(jstep + 1) * 64 + s], p_i = pwi[(jstep + 1) * 64 + s];
                    val = part ? -(c_r * p_i + c_i * p_r) : (c_r * p_r - c_i * p_i); }
                else { const int jstep = rb, h = m, i = 2 * ks + (qa >> 1), hp = 8 * (qa & 1) + jj;
                    val = (i <= jstep) ? Kt[((jstep - i) * 16 + h) * 16 + hp] + ((i == jstep && h == hp) ? dk[h] : 0.f) : 0.f; }
                v[jj] = val;
            }
            T[f] = (u32x4){cvt_pk_bf16(v[0], v[1]), cvt_pk_bf16(v[2], v[3]), cvt_pk_bf16(v[4], v[5]), cvt_pk_bf16(v[6], v[7])};
        }
    }
    __syncthreads();
}

template <int PASS>
__device__ __forceinline__ void s5_chunk(unsigned char* ws, int j, int g, int c, LAS unsigned char* lds, int lane, f32x4 (&xr)[4], f32x4 (&xi)[4]) {
    const bf16_t* U = (const bf16_t*)(ws + WS_U); bf16_t* Z = (bf16_t*)(ws + WS_Z); float* SL = (float*)(ws + WS_SLOC);
    const int n = lane & 15, q = lane >> 4;
    const int t0 = c < NCH ? NMETA + c * CL : 0, nblk = c < NCH ? CL / 8 : NMETA / 8;
    const LAS float* a8 = (const LAS float*)(lds + 3 * 32768);
    const bf16_t* ub = U + (size_t)g * NROWS * 16 + 8 * (q & 1);
    bf16_t* zb = (bf16_t*)(ws + WS_ZM) + (size_t)g * 256 + 4 * q;
    unsigned char* z8b = ws + WS_Z8 + (size_t)g * NROWS * 16 + 4 * q;
    auto ldu = [&](int tt) -> u32x4 { tt = tt < TT ? tt : TT - 1; return *(const u32x4*)(ub + (size_t)rowidx(n, tt) * 16); };
#define S5_FRAG(mat, rb, ks) (*(const LAS s16x8*)(lds + ((((mat) * 8 + (rb)) * 4 + (ks)) * 64 + lane) * 16))
    constexpr int G0 = PASS == 2 ? 0 : 8;
    s16x8 fa[2][8];
    auto loadg = [&](const int gi, s16x8 (&buf)[8]) {
        if (gi < 8) { const int hh = gi >> 2, ks = gi & 3;
#pragma unroll
            for (int r4 = 0; r4 < 4; ++r4) { buf[r4] = S5_FRAG(1, 4 * hh + r4, ks); buf[4 + r4] = S5_FRAG(2, 4 * hh + r4, ks); } }
        else { const int ks = gi - 8;
#pragma unroll
            for (int rb = 0; rb < 8; ++rb) buf[rb] = S5_FRAG(0, rb, ks); }
    };
    s16x8 wf[3][8];
    if (PASS == 1) {
#pragma unroll
        for (int ks = 0; ks < 3; ++ks)
#pragma unroll
            for (int rb = 0; rb < 8; ++rb) wf[ks][rb] = S5_FRAG(0, rb, ks);
    }
    u32x4 cu[4];
#pragma unroll
    for (int ks = 0; ks < 4; ++ks) cu[ks] = ldu(t0 + 2 * ks + (q >> 1));
#pragma unroll 1
    for (int blk = 0; blk < nblk; ++blk) {
        const int tb = t0 + 8 * blk;
        u32x4 nu[4];
#pragma unroll
        for (int ks = 0; ks < 4; ++ks) nu[ks] = ldu(tb + 8 + 2 * ks + (q >> 1));
        s16x8 ubf[4], xb[4];
#pragma unroll
        for (int ks = 0; ks < 4; ++ks) { union { u32x4 u; s16x8 s; } cv; cv.u = cu[ks]; ubf[ks] = cv.s; xb[ks] = cv.s; }
        if (PASS == 2) { union { u32x4 u; s16x8 s; } cv;
            cv.u = gm::pack8(xr[0], xr[1]); xb[0] = cv.s; cv.u = gm::pack8(xr[2], xr[3]); xb[1] = cv.s;
            cv.u = gm::pack8(xi[0], xi[1]); xb[2] = cv.s; cv.u = gm::pack8(xi[2], xi[3]); xb[3] = cv.s; }
        f32x4 acc[8];
#pragma unroll
        for (int k = 0; k < 8; ++k) acc[k] = (f32x4){0.f, 0.f, 0.f, 0.f};
        if (PASS == 2) loadg(G0, fa[G0 & 1]); else loadg(11, fa[1]);
#pragma unroll
        for (int gi = G0; gi < 12; ++gi) {
            if (PASS == 2 && gi + 1 < 12) loadg(gi + 1, fa[(gi + 1) & 1]);
            s16x8 (&f)[8] = (PASS == 1 && gi < 11) ? wf[gi >= 8 && gi < 11 ? gi - 8 : 0] : fa[gi & 1];
            if (gi < 8) { const int hh = gi >> 2, ks = gi & 3;
#pragma unroll
                for (int r4 = 0; r4 < 4; ++r4) { acc[r4] = __builtin_amdgcn_mfma_f32_16x16x32_bf16(f[r4], xb[ks], acc[r4], 0, 0, 0); acc[4 + r4] = __builtin_amdgcn_mfma_f32_16x16x32_bf16(f[4 + r4], ubf[ks], acc[4 + r4], 0, 0, 0); }
                if (ks == 3) {
#pragma unroll
                    for (int r4 = 0; r4 < 4; ++r4) { const f32x4 y = acc[r4] + acc[4 + r4]; f32x4 z;
#pragma unroll
                        for (int i = 0; i < 4; ++i) { const float v = y[i]; z[i] = v * sigmoid_f(1.5957691216f * (v + 0.044715f * v * v * v)); }
                        if (c < NCH) { const f32x4 zc = __builtin_elementwise_min(z * 16.f, (f32x4){440.f, 440.f, 440.f, 440.f});
                            *(unsigned*)(z8b + (size_t)rowidx(n, tb + 4 * hh + r4) * 16) = cvt_pk4_fp8(zc[0], zc[1], zc[2], zc[3]); }
                        else *(u32x2*)(zb + (size_t)(tb + 4 * hh + r4) * 16) = (u32x2){cvt_pk_bf16(z[0], z[1]), cvt_pk_bf16(z[2], z[3])};
                        acc[r4] = (f32x4){0.f, 0.f, 0.f, 0.f}; acc[4 + r4] = (f32x4){0.f, 0.f, 0.f, 0.f}; }
                }
            } else { const int ks = gi - 8;
#pragma unroll
                for (int rb = 0; rb < 8; ++rb) acc[rb] = __builtin_amdgcn_mfma_f32_16x16x32_bf16(f[rb], ubf[ks], acc[rb], 0, 0, 0);
            }
            __builtin_amdgcn_sched_barrier(0);
        }
#pragma unroll
        for (int r = 0; r < 4; ++r) { const f32x4 ar = *(const LAS f32x4*)(a8 + 16 * r + 4 * q), ai = *(const LAS f32x4*)(a8 + NST + 16 * r + 4 * q);
            const f32x4 nr = ar * xr[r] - ai * xi[r] + acc[r], ni = ar * xi[r] + ai * xr[r] + acc[4 + r]; xr[r] = nr; xi[r] = ni; }
#pragma unroll
        for (int ks = 0; ks < 4; ++ks) cu[ks] = nu[ks];
    }
#undef S5_FRAG
    if (PASS == 1) {
        float* sp = SL + ((size_t)(g * (NCH + 1) + c) * 32) * 64 + lane;
#pragma unroll
        for (int r = 0; r < 4; ++r)
#pragma unroll
            for (int i = 0; i < 4; ++i) { sp[(r * 4 + i) * 64] = xr[r][i]; sp[(16 + r * 4 + i) * 64] = xi[r][i]; }
    }
}
template <int PASS>
__device__ __forceinline__ void s5_scan(const Params& P, int j, LAS unsigned char* lds, int wave, int lane) {
    unsigned char* ws = P.ws; const int tid = wave * 64 + lane, q = lane >> 4;
    for (int bj = blockIdx.x; bj < 2 * NG; bj += gridDim.x) {
        const int g = bj >> 1, half = bj & 1;
        int c = half * 8 + wave;
        f32x4 xr0[4], xi0[4];
#pragma unroll
        for (int r = 0; r < 4; ++r) { xr0[r] = (f32x4){0.f, 0.f, 0.f, 0.f}; xi0[r] = xr0[r]; }
        __syncthreads();
        if (PASS == 2) {
            { const unsigned char* src = ws + WS_SLOC + (size_t)g * (NCH + 1) * 8192;
#pragma unroll
              for (int o = 0; o < (NCH + 1) * 8192; o += NTHR * 16) __builtin_amdgcn_global_load_lds((const unsigned*)(src + o + tid * 16), (LAS unsigned*)(lds + o + wave * 1024), 16, 0, 0);
              VM_WAIT(); }
            __syncthreads();
            const float* TL = (const float*)(ws + WS_S5L) + (size_t)(j * NG + g) * 2 * NST;
            f32x4 lr[4], li[4];
#pragma unroll
            for (int r = 0; r < 4; ++r) { lr[r] = *(const f32x4*)(TL + 16 * r + 4 * q); li[r] = *(const f32x4*)(TL + NST + 16 * r + 4 * q); }
            { const LAS float* sp = (const LAS float*)(lds + NCH * 8192) + lane;
#pragma unroll
              for (int r = 0; r < 4; ++r)
#pragma unroll
                  for (int i = 0; i < 4; ++i) { xr0[r][i] = sp[(r * 4 + i) * 64]; xi0[r][i] = sp[(16 + r * 4 + i) * 64]; } }
            for (int cc = 0; cc < c; ++cc) {
                const LAS float* sp = (const LAS float*)(lds + cc * 8192) + lane;
#pragma unroll
                for (int r = 0; r < 4; ++r) { f32x4 sr, si;
#pragma unroll
                    for (int i = 0; i < 4; ++i) { sr[i] = sp[(r * 4 + i) * 64]; si[i] = sp[(16 + r * 4 + i) * 64]; }
                    const f32x4 nr = lr[r] * xr0[r] - li[r] * xi0[r] + sr, ni = lr[r] * xi0[r] + li[r] * xr0[r] + si; xr0[r] = nr; xi0[r] = ni; }
            }
            __syncthreads();
        }
        { const unsigned char* src = ws + WS_S5T + (size_t)(j * NG + g) * 3 * 32768; const int nbytes = PASS == 1 ? 32768 : 3 * 32768;
#pragma unroll
          for (int o = 0; o < nbytes; o += NTHR * 16) __builtin_amdgcn_global_load_lds((const unsigned*)(src + o + tid * 16), (LAS unsigned*)(lds + o + wave * 1024), 16, 0, 0);
          { const int t2 = wave * 64 + opaque_lane();
            if (t2 < 128) ((LAS float*)(lds + 3 * 32768))[t2] = ((const float*)(ws + WS_S5A))[(size_t)(j * NG + g) * 2 * NST + t2]; }
          VM_WAIT(); }
        __syncthreads();
        if (PASS == 1) { if (c == NCH - 1) c = NCH; s5_chunk<1>(ws, j, g, c, lds, lane, xr0, xi0); }
        else { const int nrun = (c == 0) ? 2 : 1;
#pragma unroll 1
            for (int rr = 0; rr < nrun; ++rr) {
                if (rr) {
#pragma unroll
                    for (int r = 0; r < 4; ++r) { xr0[r] = (f32x4){0.f, 0.f, 0.f, 0.f}; xi0[r] = xr0[r]; } }
                s5_chunk<2>(ws, j, g, rr ? NCH : c, lds, lane, xr0, xi0); } }
    }
}

template <int W>
__device__ __forceinline__ void pool_item8(const bf16_t* U, bf16_t* H, unsigned char* H8, const float* scale, int b, int tt0, int c8) {
    u32x4 r[W + 7], hv[8];
#pragma unroll
    for (int k = 0; k < W + 7; ++k) { const int tt = tt0 - (W - 1) + k; r[k] = (u32x4){0u, 0u, 0u, 0u}; if (tt >= 0) r[k] = *(const u32x4*)(U + (size_t)rowidx(b, tt) * D + c8 * 8); }
#pragma unroll
    for (int o = 0; o < 8; ++o) hv[o] = *(const u32x4*)(H + (size_t)rowidx(b, tt0 + o) * D + c8 * 8);
    const f32x4 sc0 = *(const f32x4*)(scale + c8 * 8), sc1 = *(const f32x4*)(scale + c8 * 8 + 4);
    f32x4 s0 = (f32x4){0.f, 0.f, 0.f, 0.f}, s1 = s0;
#pragma unroll
    for (int k = 0; k < W - 1; ++k) { f32x4 a, c; gm::unpack8(r[k], a, c); s0 += a; s1 += c; }
#pragma unroll
    for (int o = 0; o < 8; ++o) {
        f32x4 a, c; gm::unpack8(r[o + W - 1], a, c); s0 += a; s1 += c;
        if (o > 0) { f32x4 pa, pc; gm::unpack8(r[o - 1], pa, pc); s0 -= pa; s1 -= pc; }
        const int tt = tt0 + o; const float inv = 1.0f / (float)((tt + 1) < W ? (tt + 1) : W);
        f32x4 h0, h1; gm::unpack8(hv[o], h0, h1);
        h0 += (s0 * inv - a) * sc0; h1 += (s1 * inv - c) * sc1;
        const size_t off = (size_t)rowidx(b, tt) * D + c8 * 8;
        *(u32x4*)(H + off) = gm::pack8(h0, h1);
        *(u32x2*)(H8 + off) = (u32x2){cvt_pk4_fp8(h0[0], h0[1], h0[2], h0[3]), cvt_pk4_fp8(h1[0], h1[1], h1[2], h1[3])};
    }
}
__device__ __forceinline__ void pool_phase(const Params& P, int j, int wave, int lane) {
    const bf16_t* U = (const bf16_t*)(P.ws + WS_U); bf16_t* H = (bf16_t*)(P.ws + WS_H); unsigned char* H8 = P.ws + WS_H8; const float* scale = P.in[I_PSCALE] + j * D;
    const int NGT = gridDim.x * NTHR;
    constexpr int NIT = (NREAL / 8 + NMETA / 8) * 256;
    for (int it = blockIdx.x * NTHR + wave * 64 + lane; it < NIT; it += NGT) {
        const int c8 = it & 255, pb = it >> 8, g = c8 >> 6;
        const int b = pb < NREAL / 8 ? (pb >> 8) : 0, tt0 = pb < NREAL / 8 ? ((pb & 255) * 8 + NMETA) : (pb - NREAL / 8) * 8;
        if (g == 0) pool_item8<2>(U, H, H8, scale, b, tt0, c8); else if (g == 1) pool_item8<4>(U, H, H8, scale, b, tt0, c8); else if (g == 2) pool_item8<8>(U, H, H8, scale, b, tt0, c8); else pool_item8<16>(U, H, H8, scale, b, tt0, c8);
    }
}

__device__ __forceinline__ void router_phase(const Params& P, int i, LAS unsigned char* lds, int wave, int lane) {
    unsigned char* ws = P.ws;
    const bf16_t* H = (const bf16_t*)(ws + WS_H); const u32x4* RT = (const u32x4*)(ws + WS_RT) + (size_t)i * 64 * 3 * 64 + lane;
    unsigned* cnt = (unsigned*)ws + CW_CNT + i * 64; u32x4* SI0 = (u32x4*)(ws + WS_SINF); u32x4* SI1 = (u32x4*)(ws + WS_SINF + SI_RANK);
    LAS float* lg = (LAS float*)(lds + LDS_STAGE) + wave * (32 * 49);
    LAS float* lb = (LAS float*)(lds + LDS_STAGE) + 8 * (32 * 49);
    __syncthreads();
    if (wave == 0 && lane < 36) lb[lane] = lane < 4 ? P.in[I_BC][i * 4 + lane] : P.in[I_BF][i * 32 + lane - 4];
    __syncthreads();
    const int NGW = gridDim.x * NWAVES, tok = lane & 15, q = lane >> 4;
    LAS float* px = (LAS float*)(lds + LDS_STAGE) + 8 * (32 * 49) + 64;
    LAS unsigned* lcnt = (LAS unsigned*)(lds + LDS_STAGE) + 20480;
    LAS unsigned* lbase = lcnt + 256;
    const int wq = wave & 3, kh = wave >> 2, njobs = (NROWS + 31) / 32;
    for (int base = 0; base + (int)blockIdx.x < njobs; base += 4 * (int)gridDim.x) {
        const int jb = base + wq * (int)gridDim.x + (int)blockIdx.x; const bool live = jb < njobs; const int job = live ? jb : 0;
        if (wave * 64 + lane < 64 + NCLS) lcnt[wave * 64 + lane] = 0u;
        const int row0 = job * 32;
        const bf16_t* hp = H + (size_t)(row0 + tok) * D + 8 * q;
        const size_t hb_off = (row0 + 16 < NROWS) ? (size_t)16 * D : 0;
        f32x4 a0 = (f32x4){0.f, 0.f, 0.f, 0.f}, a1 = a0, a2 = a0, b0 = a0, b1 = a0, b2 = a0; float ssa = 0.f, ssb = 0.f;
        if (live) {
#pragma unroll 8
        for (int ks = 32 * kh; ks < 32 * kh + 32; ++ks) {
            const u32x4 ha = *(const u32x4*)(hp + 32 * ks), hb = *(const u32x4*)(hp + hb_off + 32 * ks);
            const u32x4 w0 = RT[(ks * 3 + 0) * 64], w1 = RT[(ks * 3 + 1) * 64], w2 = RT[(ks * 3 + 2) * 64];
            { const float f0 = bf_lo(ha.x), f1 = bf_hi(ha.x), f2 = bf_lo(ha.y), f3 = bf_hi(ha.y), f4 = bf_lo(ha.z), f5 = bf_hi(ha.z), f6 = bf_lo(ha.w), f7 = bf_hi(ha.w);
              ssa += (f0 * f0 + f1 * f1) + (f2 * f2 + f3 * f3) + (f4 * f4 + f5 * f5) + (f6 * f6 + f7 * f7); }
            { const float f0 = bf_lo(hb.x), f1 = bf_hi(hb.x), f2 = bf_lo(hb.y), f3 = bf_hi(hb.y), f4 = bf_lo(hb.z), f5 = bf_hi(hb.z), f6 = bf_lo(hb.w), f7 = bf_hi(hb.w);
              ssb += (f0 * f0 + f1 * f1) + (f2 * f2 + f3 * f3) + (f4 * f4 + f5 * f5) + (f6 * f6 + f7 * f7); }
            union { u32x4 u; s16x8 s; } ca, cb, c0, c1, c2; ca.u = ha; cb.u = hb; c0.u = w0; c1.u = w1; c2.u = w2;
            a0 = __builtin_amdgcn_mfma_f32_16x16x32_bf16(c0.s, ca.s, a0, 0, 0, 0);
            a1 = __builtin_amdgcn_mfma_f32_16x16x32_bf16(c1.s, ca.s, a1, 0, 0, 0);
            a2 = __builtin_amdgcn_mfma_f32_16x16x32_bf16(c2.s, ca.s, a2, 0, 0, 0);
            b0 = __builtin_amdgcn_mfma_f32_16x16x32_bf16(c0.s, cb.s, b0, 0, 0, 0);
            b1 = __builtin_amdgcn_mfma_f32_16x16x32_bf16(c1.s, cb.s, b1, 0, 0, 0);
            b2 = __builtin_amdgcn_mfma_f32_16x16x32_bf16(c2.s, cb.s, b2, 0, 0, 0);
        } }
        { LAS float* pp = px + wq * (26 * 64) + lane;
          if (kh == 1) {
#pragma unroll
              for (int r = 0; r < 4; ++r) { pp[(0 + r) * 64] = a0[r]; pp[(4 + r) * 64] = a1[r]; pp[(8 + r) * 64] = a2[r]; pp[(12 + r) * 64] = b0[r]; pp[(16 + r) * 64] = b1[r]; pp[(20 + r) * 64] = b2[r]; }
              pp[24 * 64] = ssa; pp[25 * 64] = ssb; }
          __syncthreads();
          if (kh == 0) {
#pragma unroll
              for (int r = 0; r < 4; ++r) { a0[r] += pp[(0 + r) * 64]; a1[r] += pp[(4 + r) * 64]; a2[r] += pp[(8 + r) * 64]; b0[r] += pp[(12 + r) * 64]; b1[r] += pp[(16 + r) * 64]; b2[r] += pp[(20 + r) * 64]; }
              ssa += pp[24 * 64]; ssb += pp[25 * 64]; }
          __syncthreads(); }
        const bool act = (kh == 0) && live;
        bool tokv = false; int ea = 0, eb = 0, cls = 0, trow = 0, swp = 0; float wa = 0.f, wb = 0.f, rstd = 0.f; unsigned la = 0u, lbi = 0u, lc = 0u;
        if (act) {
            ssa += __shfl_xor(ssa, 16); ssa += __shfl_xor(ssa, 32); ssb += __shfl_xor(ssb, 16); ssb += __shfl_xor(ssb, 32);
            const float rsa = rsqrtf(ssa * (1.0f / D) + RMS_EPS), rsb = rsqrtf(ssb * (1.0f / D) + RMS_EPS);
#pragma unroll
            for (int r = 0; r < 4; ++r) {
                lg[tok * 49 + 4 * q + r] = a0[r] * rsa; lg[tok * 49 + 16 + 4 * q + r] = a1[r] * rsa; lg[tok * 49 + 32 + 4 * q + r] = a2[r] * rsa;
                lg[(16 + tok) * 49 + 4 * q + r] = b0[r] * rsb; lg[(16 + tok) * 49 + 16 + 4 * q + r] = b1[r] * rsb; lg[(16 + tok) * 49 + 32 + 4 * q + r] = b2[r] * rsb; }
            const float rs_b = __shfl(rsb, lane & 15);
            LDS_WAIT();
            if (lane < 32 && row0 + lane < NROWS) {
                rstd = lane < 16 ? rsa : rs_b;
                const LAS float* l = lg + lane * 49;
                float cm = l[0] + lb[0]; int grp = 0;
#pragma unroll
                for (int k = 1; k < 4; ++k) { const float v = l[k] + lb[k]; if (v > cm) { cm = v; grp = k; } }
                float cs = 0.f;
#pragma unroll
                for (int k = 0; k < 4; ++k) cs += __expf(l[k] + lb[k] - cm);
                const float pg = 1.0f / cs;
                float f1 = -3.0e38f, f2 = -3.0e38f; int e1 = 0, e2 = 0;
#pragma unroll
                for (int k = 0; k < 8; ++k) { const float v = l[4 + 8 * grp + k] + lb[4 + 8 * grp + k];
                    if (v > f1) { f2 = f1; e2 = e1; f1 = v; e1 = k; } else if (v > f2) { f2 = v; e2 = k; } }
                const float ex = __expf(f2 - f1); wa = pg / (1.0f + ex); wb = pg * ex / (1.0f + ex);
                ea = 8 * grp + e1; eb = 8 * grp + e2; trow = row0 + lane; swp = e1 > e2 ? 1 : 0;
                const int lo = e1 < e2 ? e1 : e2, hi2 = e1 < e2 ? e2 : e1; cls = 28 * grp + (lo * (15 - lo)) / 2 + (hi2 - lo - 1);
                la = __hip_atomic_fetch_add(lcnt + ea, 1u, __ATOMIC_RELAXED, __HIP_MEMORY_SCOPE_WORKGROUP);
                lbi = __hip_atomic_fetch_add(lcnt + 32 + eb, 1u, __ATOMIC_RELAXED, __HIP_MEMORY_SCOPE_WORKGROUP);
                lc = __hip_atomic_fetch_add(lcnt + 64 + cls, 1u, __ATOMIC_RELAXED, __HIP_MEMORY_SCOPE_WORKGROUP);
                tokv = true;
            }
        }
        __syncthreads();
        { const int t = wave * 64 + lane;
          if (t < 64 + NCLS) { const unsigned n = lcnt[t];
              if (n) lbase[t] = __hip_atomic_fetch_add(t < 64 ? cnt + t : cnt + (CW_CC - CW_CNT) + (128 - 64) * i + (t - 64), n, __ATOMIC_RELAXED, __HIP_MEMORY_SCOPE_AGENT); } }
        __syncthreads();
        if (tokv) {
            const unsigned pa = lbase[ea] + la, pb = lbase[32 + eb] + lbi, pc = lbase[64 + cls] + lc;
            ((float*)(ws + WS_RQ))[trow] = rstd;
            SI0[(size_t)ea * CAP + pa] = (u32x4){(unsigned)trow, __float_as_uint(wa), __float_as_uint(rstd), 0u};
            SI1[(size_t)eb * CAP + pb] = (u32x4){(unsigned)trow, __float_as_uint(wb), __float_as_uint(rstd), 0u};
            ((u32x4*)(ws + WS_SC))[(size_t)cls * CAP + pc] = (u32x4){(unsigned)trow | (swp ? 0x80000000u : 0u), 0u, __float_as_uint(rstd), 0u};
        }
    }
}

__device__ __forceinline__ void moe_tables(const Params& P, int i, LAS int* misc, int wave, int lane) {
    __syncthreads();
    if (wave == 0) {
        const unsigned* cnt = (const unsigned*)P.ws + CW_CNT + i * 64;
        const int n0 = lane < 32 ? (int)__hip_atomic_load(cnt + (lane & 31), __ATOMIC_RELAXED, __HIP_MEMORY_SCOPE_AGENT) : 0;
        const int n1 = lane < 32 ? (int)__hip_atomic_load(cnt + 32 + (lane & 31), __ATOMIC_RELAXED, __HIP_MEMORY_SCOPE_AGENT) : 0;
        int tg = (n0 + n1 + 255) >> 8, ta = (n0 + 255) >> 8, tb = (n1 + 255) >> 8, sl = n0 + n1;
#pragma unroll
        for (int o = 1; o < 32; o <<= 1) { const int a1 = __shfl_up(tg, o), a2 = __shfl_up(ta, o), a3 = __shfl_up(tb, o), a4 = __shfl_up(sl, o); if (lane >= o) { tg += a1; ta += a2; tb += a3; sl += a4; } }
        if (lane < 32) { misc[16 + lane + 1] = tg; misc[64 + lane + 1] = sl; misc[112 + lane + 1] = ta; misc[160 + lane + 1] = tb; misc[208 + lane] = n0; }
        if (lane == 0) { misc[16] = 0; misc[64] = 0; misc[112] = 0; misc[160] = 0; }
    }
    if (wave == 1) {
        const unsigned* cc = (const unsigned*)P.ws + CW_CC + i * 128;
        const int na = lane < 56 ? (int)__hip_atomic_load(cc + 2 * lane, __ATOMIC_RELAXED, __HIP_MEMORY_SCOPE_AGENT) : 0;
        const int nb = lane < 56 ? (int)__hip_atomic_load(cc + 2 * lane + 1, __ATOMIC_RELAXED, __HIP_MEMORY_SCOPE_AGENT) : 0;
        const int fa = (na >> 8) + ((na & 255) > 128 ? 1 : 0), fb = (nb >> 8) + ((nb & 255) > 128 ? 1 : 0);
        const int ha = ((na & 255) >= 1 && (na & 255) <= 128) ? 1 : 0, hb = ((nb & 255) >= 1 && (nb & 255) <= 128) ? 1 : 0;
        int sf = fa + fb, sh = ha + hb;
#pragma unroll
        for (int o = 1; o < 64; o <<= 1) { const int a1 = __shfl_up(sf, o), a2 = __shfl_up(sh, o); if (lane >= o) { sf += a1; sh += a2; } }
        if (lane < 56) { misc[256 + 2 * lane + 1] = sf - fb; misc[256 + 2 * lane + 2] = sf; misc[384 + 2 * lane + 1] = sh - hb; misc[384 + 2 * lane + 2] = sh; misc[512 + 2 * lane] = na; misc[512 + 2 * lane + 1] = nb; }
        if (lane == 0) { misc[256] = 0; misc[384] = 0; }
        if (lane < 28) { int lo = 0, r = lane;
#pragma unroll
            for (int k = 0; k < 7; ++k) if (r >= 7 - lo) { r -= 7 - lo; ++lo; }
            misc[640 + lane] = lo | ((lo + 1 + r) << 4); }
    }
    __syncthreads();
}

__device__ __forceinline__ void finalize_phase(const Params& P, int i, int wave, int lane) {
    unsigned char* ws = P.ws; const float* SSP = (const float*)(ws + WS_SSP);
    if (i < 3) {
        float* RS = (float*)(ws + WS_RSTD); const int NGT = gridDim.x * NTHR;
        for (int row = blockIdx.x * NTHR + wave * 64 + lane; row < NROWS; row += NGT) {
            const f32x4* p = (const f32x4*)(SSP + (size_t)row * 32); f32x4 a = p[0];
#pragma unroll
            for (int k = 1; k < 8; ++k) a += p[k];
            RS[row] = rsqrtf(((a[0] + a[1]) + (a[2] + a[3])) * (1.0f / D) + RMS_EPS);
        }
    } else {
        const bf16_t* H = (const bf16_t*)(ws + WS_H); const float* gf = P.in[I_NFIN]; const int NGW = gridDim.x * NWAVES;
        for (int row0 = blockIdx.x * NWAVES + wave; row0 < NREAL; row0 += 4 * NGW) {
            float sp[4]; u32x4 hv[4][4];
#pragma unroll
            for (int r = 0; r < 4; ++r) { const int row = row0 + r * NGW; sp[r] = (lane < 32 && row < NREAL) ? SSP[(size_t)row * 32 + lane] : 0.f;
#pragma unroll
                for (int jj = 0; jj < 4; ++jj) { hv[r][jj] = (u32x4){0u, 0u, 0u, 0u}; if (row < NREAL) hv[r][jj] = *(const u32x4*)(H + (size_t)row * D + lane * 8 + 512 * jj); } }
#pragma unroll
            for (int r = 0; r < 4; ++r) { const int row = row0 + r * NGW; if (row >= NREAL) break;
                const float rstd = rsqrtf(wave_sum(sp[r]) * (1.0f / D) + RMS_EPS);
#pragma unroll
                for (int jj = 0; jj < 4; ++jj) { const int c = lane * 8 + 512 * jj; f32x4 h0, h1; gm::unpack8(hv[r][jj], h0, h1);
                    *(f32x4*)(P.out + (size_t)row * D + c) = h0 * rstd * *(const f32x4*)(gf + c);
                    *(f32x4*)(P.out + (size_t)row * D + c + 4) = h1 * rstd * *(const f32x4*)(gf + c + 4); } }
        }
    }
}

constexpr int NPHASE = 39;
__global__ void __launch_bounds__(NTHR, 2) trunk_fwd(Params P) {
    extern __shared__ __attribute__((aligned(16))) unsigned char lds_raw[];
    LAS unsigned char* lds = (LAS unsigned char*)lds_raw;
    LAS int* misc = (LAS int*)(lds + LDS_MISC);
    const int wave0 = __builtin_amdgcn_readfirstlane(threadIdx.x >> 6);
    if (threadIdx.x < 128) misc[threadIdx.x] = 0;
    __syncthreads();
    XcdBarrier bar; bar.bar = (unsigned*)P.ws; bar.x = 0; bar.st = nullptr;
    if (ONE_LAUNCH) bar = xcd_barrier_post((unsigned*)P.ws, (volatile LAS unsigned*)misc);
    const int lo = P.ph_lo, hi = P.ph_hi;
#define IN(k) (lo <= (k) && (k) < hi)
#define SEAM(k) do { if (ONE_LAUNCH) { if (IN(k) && IN((k) + 1)) xcd_barrier(bar); } } while (0)
    LAS unsigned char* stage = lds + LDS_STAGE; LAS unsigned char* linfo = lds + LDS_INFO;

    if (EN_P0 && IN(0)) { for (int rep = 0; rep < REP_P0; ++rep) { phase0(P, lds, wave0, opaque_lane()); VM_WAIT(); __syncthreads(); } }
    SEAM(0);
    if (IN(1)) {
        const int c = blockIdx.x, jl = c >> 6;
        if (c < 128) {
            gm::DenseOrder S; S.nM = 8; S.nN = 8; S.nwg = 64; S.G = 1 << 20; S.c = c & 63;
            S.A = (const char*)(P.ws + WS_GRP) + (size_t)jl * D * 512 * 2; S.aTile = (size_t)256 * 512 * 2; S.kofs_per_pn2 = 0;
            S.Bt = (const char*)(P.ws + WS_WINO) + (size_t)jl * D * D * 2; S.bTile = (size_t)256 * D * 2; S.kofsB_per_pm2 = 512 * 2;
            gm::EpiDn E{(bf16_t*)(P.ws + WS_WIN) + (size_t)(2 * jl + 1) * D * D, (unsigned*)P.ws + CW_AM + (2 * jl + 1) * D};
            gm::gemm_phase<gm::EpiDn, gm::DenseOrder, false, false>(stage, linfo, 512, 512, S, E, wave0, D);
        } else {
            const int lane = opaque_lane(); LAS float* scr = (LAS float*)(lds + LDS_STAGE) + wave0 * (64 * 65);
            for (int it = (c - 128) * NWAVES + wave0; it < 2 * 1024; it += ((int)gridDim.x - 128) * NWAVES) {
                const int i = (it >> 10) * 2, rr = it & 1023, kb = rr >> 5, nb = rr & 31;
                ConvDesc d; d.w = P.in[I_S5WIN] + (size_t)(i >> 1) * D * D + (size_t)(kb * 64) * D + nb * 64; d.gain = P.in[I_NMIX] + i * D + kb * 64;
                d.dst = P.ws + WS_WI8 + (size_t)i * D * D + kb * 64; d.ldw = D; d.Kd = D; d.kind = 0; d.off = 0; d.n0 = nb * 64; d.esz = 1; d.wscale = 1.f;
                f32x4 v[16]; conv_load(d, v, lane); conv_store_i8(d, v, scr, lane, (const unsigned*)P.ws + CW_AM + i * D);
            }
        }
    }
    SEAM(1);

#pragma unroll 1
    for (int i = 0; i < 4; ++i) {
        const int pb = 3 + 9 * i, j = i >> 1; const bool s5 = (i & 1) == 0;
        const int lane = opaque_lane();
        unsigned char* ws = P.ws; int G = gridDim.x, c = blockIdx.x, wave = wave0;
        asm volatile("" : "+s"(ws), "+s"(G), "+s"(c), "+s"(wave));
        if (EN_WIN && IN(pb + 0)) {
            gm::DenseOrder S; S.nM = NREAL / 256; S.nN = 8; S.nwg = S.nM * S.nN; S.G = G; S.c = c; S.A = (const char*)(ws + WS_H); S.Bt = (const char*)(ws + WS_WIN) + (size_t)i * D * D * 2;
            S.aTile = (size_t)256 * D * 2; S.bTile = (size_t)256 * D * 2; S.kofs_per_pn2 = 0;
            LAS float* rtab = (LAS float*)linfo; LAS float* ctab = rtab + 1024;
            { const float* RS0 = (const float*)(ws + WS_RSTD); const float* SSP = (const float*)(ws + WS_SSP); const float* RQ = (const float*)(ws + WS_RQ); const int t256 = (wave & 3) * 64 + lane, hi = wave >> 2;
              const unsigned* AM = (const unsigned*)ws + CW_AM + i * D;
              __syncthreads();
#pragma unroll
              for (int k = 0; k < 4; ++k) { const int n = (wave * 64 + lane) + 512 * k; ctab[n] = fmaxf(__uint_as_float(AM[n]), 1e-30f) * (1.0f / 127.0f); }
#pragma unroll 1
              for (int k2 = 0; k2 < 4; k2 += 2) { gm::Unit uk; if (!S.next(k2 + hi, uk)) continue;
                  int row = uk.orow + t256; asm volatile("" : "+v"(row)); float rs;
                  if (i == 0) rs = RS0[row];
                  else { const f32x4* pp = (const f32x4*)(SSP + (size_t)row * 32); f32x4 a = pp[0];
#pragma unroll
                      for (int k = 1; k < 8; ++k) a += pp[k];
                      rs = rsqrtf(((a[0] + a[1]) + (a[2] + a[3])) * (1.0f / D) + RMS_EPS); }
                  rtab[(k2 + hi) * 256 + t256] = rs * (QCLIP / 127.0f) / RQ[row]; }
              __syncthreads(); }
            S.A = (const char*)(ws + WS_HI8); S.Bt = (const char*)(ws + WS_WI8) + (size_t)i * D * D; S.aTile = (size_t)256 * D; S.bTile = (size_t)256 * D;
            gm::EpiU E{(bf16_t*)(ws + WS_U), rtab, ctab, s5 ? 1 : 0};
            gm::gemm_phase<gm::EpiU, gm::DenseOrder, false, false, false, 2>(stage, linfo, D / 2, D / 2, S, E, wave);
            if (c < 128) meta_gemm<0>(stage, (const bf16_t*)(ws + WS_WIN) + (size_t)i * D * D, D, 16 * c, 0, (const bf16_t*)(ws + WS_H) + (size_t)NREAL * D, (bf16_t*)(ws + WS_U), (const float*)(ws + WS_RSTD), c, wave, lane, s5 ? 1 : 0, nullptr, i == 0 ? nullptr : (const float*)(ws + WS_SSP));
        }
        SEAM(pb + 0);
        if (s5) {
            if (i == 0 && IN(pb + 1)) {
                for (int id = c * NTHR + wave * 64 + lane; id < 2 * D * (D / 8); id += G * NTHR) {
                    const int k8 = id & 255, n = (id >> 8) & 2047, il = 2 * (id >> 19) + 1;
                    const float qs = 127.0f / fmaxf(__uint_as_float(((const unsigned*)ws)[CW_AM + il * D + n]), 1e-30f);
                    f32x4 a, b; gm::unpack8(*(const u32x4*)((const bf16_t*)(ws + WS_WIN) + ((size_t)il * D + n) * D + k8 * 8), a, b);
                    *(u32x2*)(ws + WS_WI8 + ((size_t)il * D + n) * D + k8 * 8) = pack8_i8(a * qs, b * qs);
                }
            }
            if (EN_S51 && IN(pb + 1)) for (int rep = 0; rep < REP_S5; ++rep) s5_scan<1>(P, j, stage, wave, lane);
            SEAM(pb + 1);
            if (EN_S52 && IN(pb + 2)) for (int rep = 0; rep < REP_S5; ++rep) s5_scan<2>(P, j, stage, wave, lane);
            SEAM(pb + 2);
            if (EN_GLU && IN(pb + 3)) {
                gm::DenseOrder S; S.nM = NREAL / 256; S.nN = 16; S.nwg = S.nM * S.nN; S.G = G; S.c = c; S.A = (const char*)(ws + WS_Z8); S.Bt = (const char*)(ws + WS_GLU8) + (size_t)j * 4096 * D;
                S.aTile = (size_t)256 * 16; S.bTile = (size_t)256 * D; S.kofs_per_pn2 = 0;
                gm::EpiGlu E{(bf16_t*)(ws + WS_H), ws + WS_H8, 1.0f / 512.0f};
                gm::gemm_phase<gm::EpiGlu, gm::DenseOrder, false, false, 2, 1>(stage, linfo, D / 2, D / 2, S, E, wave);
                if (c < 128) { const int wr0 = ((16 * c) >> 7) * 256 + ((16 * c) & 127);
                    meta_gemm<1>(stage, (const bf16_t*)(ws + WS_GLU) + (size_t)j * 4096 * D, D, wr0, wr0 + 128, (const bf16_t*)(ws + WS_ZM), (bf16_t*)(ws + WS_H), nullptr, c, wave, lane, 0, ws + WS_H8); }
            }
            SEAM(pb + 3);
        } else {
            if (EN_POOL && IN(pb + 1)) pool_phase(P, j, wave, lane);
            SEAM(pb + 1);
        }
        if (EN_RT && IN(pb + 4)) router_phase(P, i, lds, wave, lane);
        SEAM(pb + 4);
        if (EN_GU && IN(pb + 5)) {
            moe_tables(P, i, misc, wave, lane);
            gm::MoeOrder S; S.nN = 4; S.G = G; S.c = c; S.mode = 0; S.tp = misc + 16; S.sbe = misc + 64; S.c0 = misc + 208; S.A = (const char*)(ws + WS_H8); S.aRow = 0;
            S.Bt = (const char*)(ws + WS_GU) + (size_t)i * 32 * 1024 * D; S.bExp = (size_t)1024 * D; S.bTile = (size_t)256 * D; S.info = (const char*)(ws + WS_SINF);
            gm::EpiGU E{(bf16_t*)(ws + WS_HID)};
            gm::gemm_phase<gm::EpiGU, gm::MoeOrder, true, true, false, 1>(stage, linfo, D / 2, D / 2, S, E, wave);
        }
        SEAM(pb + 5);
        if (EN_DN && IN(pb + 7)) {
            if (!(IN(pb + 5))) moe_tables(P, i, misc, wave, lane);
            gm::PairOrder S; S.nN = 8; S.G = G; S.c = c; S.tp = misc + 256; S.tph = misc + 384; S.ncl = misc + 512; S.ptab = misc + 640; S.A = (const char*)(ws + WS_HID);
            S.Bt = (const char*)(ws + WS_DN) + (size_t)i * 32 * D * DE; S.bExp = (size_t)D * DE; S.bTile = (size_t)256 * DE; S.info = (const char*)(ws + WS_SC);
            gm::EpiAdd<true> E{(bf16_t*)(ws + WS_H), (float*)(ws + WS_SSP), 1.0f / 256.0f, i == 3 ? nullptr : ws + WS_HI8};
            gm::gemm_phase<gm::EpiAdd<true>, gm::PairOrder, true, true, false, 1, true>(stage, linfo, DE, DE, S, E, wave, DE / 2);
        }
        SEAM(pb + 7);
        if (EN_CMB && IN(pb + 8) && i == 3) finalize_phase(P, i, wave, lane);
    }
#ifdef DBG_LAST_PHASE
    if (IN(99)) {
        const bf16_t* H = (const bf16_t*)(P.ws + DBG_SRC); const int lane = opaque_lane();
        for (int row = blockIdx.x * NWAVES + wave0; row < NREAL; row += gridDim.x * NWAVES)
            for (int jj = 0; jj < 4; ++jj) { const int c = lane * 8 + 512 * jj; f32x4 a, b; gm::unpack8(*(const u32x4*)(H + (size_t)row * D + c), a, b);
                *(f32x4*)(P.out + (size_t)row * D + c) = a; *(f32x4*)(P.out + (size_t)row * D + c + 4) = b; }
    }
#endif
#undef IN
#undef SEAM
}

extern "C" void kernel_launch(void* const* d_in, const int* in_sizes, int n_in, void* d_out, int out_size, void* d_ws, size_t ws_size, hipStream_t stream) {
    static int grid = 0;
    if (grid == 0) {
        if (n_in != 25 || ws_size < WS_END) { fprintf(stderr, "kernel_launch: expected 25 inputs and >= %zu bytes of workspace (got %d, %zu)\n", (size_t)WS_END, n_in, ws_size); grid = -1; return; }
        int dev = 0, cus = 0, per_cu = 0;
        if (hipGetDevice(&dev) != hipSuccess || hipDeviceGetAttribute(&cus, hipDeviceAttributeMultiprocessorCount, dev) != hipSuccess) { grid = -1; return; }
        if (hipFuncSetAttribute((const void*)trunk_fwd, hipFuncAttributeMaxDynamicSharedMemorySize, LDS_BYTES) != hipSuccess) { fprintf(stderr, "kernel_launch: hipFuncSetAttribute failed\n"); grid = -1; return; }
        if (hipOccupancyMaxActiveBlocksPerMultiprocessor(&per_cu, (const void*)trunk_fwd, NTHR, LDS_BYTES) != hipSuccess || per_cu < 1) { fprintf(stderr, "kernel_launch: occupancy query says %d\n", per_cu); (void)hipGetLastError(); per_cu = 1; }
        grid = cus;
    }
    if (grid < 0) return;
    (void)hipMemsetAsync(d_ws, 0, CTL_BYTES, stream);
    Params p{};
    for (int i = 0; i < 25; ++i) p.in[i] = (const float*)d_in[i];
    p.out = (float*)d_out; p.ws = (unsigned char*)d_ws;
#if ONE_LAUNCH
    p.ph_lo = 0; p.ph_hi = NPHASE;
    hipLaunchKernelGGL(trunk_fwd, dim3(grid), dim3(NTHR), LDS_BYTES, stream, p);
#else
    for (int k = 0; k < NPHASE; ++k) {
        const int li = (k - 3) / 9, loc = (k - 3) % 9;
        if (k == 2 || (k > 2 && (((li & 1) == 1 && (loc == 2 || loc == 3)) || loc == 6))) continue;
#ifdef DBG_LAST_PHASE
        if (k > DBG_LAST_PHASE) break;
#endif
        p.ph_lo = k; p.ph_hi = k + 1;
        hipLaunchKernelGGL(trunk_fwd, dim3(grid), dim3(NTHR), LDS_BYTES, stream, p);
    }
#ifdef DBG_LAST_PHASE
    p.ph_lo = 99; p.ph_hi = 100;
    hipLaunchKernelGGL(trunk_fwd, dim3(grid), dim3(NTHR), LDS_BYTES, stream, p);
#endif
#endif
}
```
